# Optimizing an MI355X kernel written in HIP

```python
import jax, jax.numpy as jnp
from jax import lax
import numpy as np

D_MODEL = 1024
BATCH = 4
SEQ = 8192
DEPTH = 1

N_Q_HEADS = 8
N_KV_HEADS = 2
HEAD_DIM = D_MODEL // 16
ATTN_WIDTH = N_Q_HEADS * HEAD_DIM
KV_WIDTH = N_KV_HEADS * HEAD_DIM
WINDOW = 128
BLOCK = 128
POOL_WIDTH = D_MODEL // 2
POOL_WINDOWS = (2, 4, 8, 16)
N_POOL_GROUPS = 4
POOL_GROUP = POOL_WIDTH // N_POOL_GROUPS
IN_WIDTH = ATTN_WIDTH + 2 * KV_WIDTH + ATTN_WIDTH + 2 * POOL_WIDTH + 2 * D_MODEL
EPS = 1e-6
NEG_INF = -1e30

kernel_name = "hybrid_gated_swa_pool_encoder"


def rms_norm(x, g):
    xf = x.astype(jnp.float32)
    xf = xf * lax.rsqrt(jnp.mean(xf * xf, axis=-1, keepdims=True) + EPS)
    return (xf * g.astype(jnp.float32)).astype(x.dtype)


def windowed_gqa(q, k, v, sink):
    B, S, _ = q.shape
    nb = S // BLOCK
    G = N_Q_HEADS // N_KV_HEADS
    qb = q.reshape(B, nb, BLOCK, N_KV_HEADS, G, HEAD_DIM)
    pad = ((0, 0), (BLOCK, BLOCK), (0, 0))
    kp = jnp.pad(k, pad).reshape(B, nb + 2, BLOCK, N_KV_HEADS, HEAD_DIM)
    vp = jnp.pad(v, pad).reshape(B, nb + 2, BLOCK, N_KV_HEADS, HEAD_DIM)
    kw = jnp.concatenate([kp[:, :-2], kp[:, 1:-1], kp[:, 2:]], axis=2)
    vw = jnp.concatenate([vp[:, :-2], vp[:, 1:-1], vp[:, 2:]], axis=2)

    scale = HEAD_DIM ** -0.5
    scores = jnp.einsum('bnqhgd,bnkhd->bnhgqk', qb, kw,
                        preferred_element_type=jnp.float32) * scale

    r = jnp.arange(BLOCK)
    j = jnp.arange(3 * BLOCK)
    rel = r[:, None] - (j[None, :] - BLOCK)
    dist = jnp.abs(rel).astype(jnp.float32)
    kpos = jnp.arange(nb)[:, None] * BLOCK - BLOCK + j[None, :]
    valid = (kpos >= 0) & (kpos < S)
    mask = (jnp.abs(rel) <= WINDOW)[None] & valid[:, None, :]

    slopes = jnp.exp2(-8.0 * jnp.arange(1, N_Q_HEADS + 1, dtype=jnp.float32) / N_Q_HEADS)
    slopes = slopes.reshape(N_KV_HEADS, G)
    alibi = -slopes[:, :, None, None] * dist[None, None]
    scores = jnp.where(mask[None, :, None, None], scores + alibi[None, None], NEG_INF)

    sink_f = sink.astype(jnp.float32).reshape(N_KV_HEADS, G)[None, None, :, :, None]
    m = jnp.maximum(jnp.max(scores, axis=-1), sink_f)
    p = jnp.exp(scores - m[..., None])
    denom = jnp.sum(p, axis=-1) + jnp.exp(sink_f - m)
    out = jnp.einsum('bnhgqk,bnkhd->bnqhgd', p, vw.astype(jnp.float32))
    out = out / jnp.transpose(denom, (0, 1, 4, 2, 3))[..., None]
    return out.reshape(B, S, ATTN_WIDTH).astype(q.dtype)


def multiscale_pool(u, pool_w, pool_scale):
    B, S, _ = u.shape
    uf = u.astype(jnp.float32).reshape(B, S, N_POOL_GROUPS, POOL_GROUP)
    csum = jnp.pad(jnp.cumsum(uf, axis=1), ((0, 0), (1, 0), (0, 0), (0, 0)))
    t = jnp.arange(S)
    outs = []
    for gi, w in enumerate(POOL_WINDOWS):
        lo = jnp.clip(t - w // 2, 0, S)
        hi = jnp.clip(t + w // 2, 0, S)
        window_sum = csum[:, hi, gi] - csum[:, lo, gi]
        outs.append(window_sum / (hi - lo).astype(jnp.float32)[None, :, None])
    pooled = jnp.stack(outs, axis=2) - uf
    mixed = jnp.einsum('bsgc,gcd->bsgd', pooled.astype(u.dtype), pool_w)
    mixed = mixed * pool_scale.reshape(N_POOL_GROUPS, POOL_GROUP)
    return mixed.reshape(B, S, POOL_WIDTH)


def setup_inputs(seed: int = 0) -> dict:
    key = jax.random.key(seed)
    ks = jax.random.split(key, 11)
    f32 = jnp.float32
    x = jax.random.normal(ks[0], (BATCH, SEQ, D_MODEL), f32)
    norm_g = 1.0 + 0.1 * jax.random.normal(ks[1], (DEPTH, D_MODEL), f32)
    w_in = jax.random.normal(ks[2], (DEPTH, D_MODEL, IN_WIDTH), f32) * D_MODEL ** -0.5
    attn_sink = jax.random.normal(ks[3], (DEPTH, N_Q_HEADS), f32)
    pool_w = jax.random.normal(ks[4], (DEPTH, N_POOL_GROUPS, POOL_GROUP, POOL_GROUP), f32) * POOL_GROUP ** -0.5
    pool_scale = 1.0 + 0.1 * jax.random.normal(ks[5], (DEPTH, POOL_WIDTH), f32)
    w_branch_a = jax.random.normal(ks[6], (DEPTH, ATTN_WIDTH, D_MODEL), f32) * ATTN_WIDTH ** -0.5
    w_branch_b = jax.random.normal(ks[7], (DEPTH, POOL_WIDTH, D_MODEL), f32) * POOL_WIDTH ** -0.5
    w_out = jax.random.normal(ks[8], (DEPTH, D_MODEL, D_MODEL), f32) * D_MODEL ** -0.5
    final_norm_g = 1.0 + 0.1 * jax.random.normal(ks[9], (D_MODEL,), f32)
    return {"x": x, "norm_g": norm_g, "w_in": w_in, "attn_sink": attn_sink,
            "pool_w": pool_w, "pool_scale": pool_scale, "w_branch_a": w_branch_a,
            "w_branch_b": w_branch_b, "w_out": w_out, "final_norm_g": final_norm_g}


def reference(x, norm_g, w_in, attn_sink, pool_w, pool_scale, w_branch_a, w_branch_b, w_out, final_norm_g):
    widths = (ATTN_WIDTH, KV_WIDTH, KV_WIDTH, ATTN_WIDTH, POOL_WIDTH, POOL_WIDTH, D_MODEL)
    offsets = []
    acc = 0
    for wd in widths:
        acc += wd
        offsets.append(acc)
    for l in range(DEPTH):
        h = rms_norm(x, norm_g[l])
        proj = jnp.einsum('bsd,de->bse', h, w_in[l])
        q, k, v, z_a, u_b, z_b, g_a, g_b = jnp.split(proj, offsets, axis=-1)
        attn = windowed_gqa(q, k, v, attn_sink[l]) * jax.nn.silu(z_a)
        y_a = jnp.einsum('bsc,cd->bsd', attn, w_branch_a[l])
        pool = multiscale_pool(u_b, pool_w[l], pool_scale[l]) * jax.nn.silu(z_b)
        y_b = jnp.einsum('bsc,cd->bsd', pool, w_branch_b[l])
        merged = jax.nn.sigmoid(g_a) * y_a + jax.nn.sigmoid(g_b) * y_b
        x = x + jnp.einsum('bsd,de->bse', merged, w_out[l])
    return rms_norm(x, final_norm_g)
```

```cpp
#include <hip/hip_runtime.h>
#include <hip/hip_cooperative_groups.h>
#include <cstdio>
#include <cstdint>
namespace cg = cooperative_groups;

#define LAS __attribute__((address_space(3)))
typedef unsigned short bf16_t;
typedef short bf16x8 __attribute__((ext_vector_type(8)));
typedef short s16x4 __attribute__((ext_vector_type(4)));
typedef float f32x4 __attribute__((ext_vector_type(4)));
typedef float f32x16 __attribute__((ext_vector_type(16)));
typedef unsigned u32x4 __attribute__((ext_vector_type(4)));
typedef unsigned u32x2 __attribute__((ext_vector_type(2)));

constexpr int BATCH = 4, SEQ = 8192, D = 1024, M = BATCH * SEQ;
constexpr int INW = 4352;
constexpr int C_Q = 0, C_K = 512, C_V = 640, C_ZA = 768, C_UB = 1280, C_ZB = 1792, C_GA = 2304, C_GB = 3328;
constexpr float EPS = 1e-6f;
constexpr float LOG2E = 1.4426950408889634f;
constexpr float QSCALE2 = 0.125f * LOG2E;
constexpr int NWAVES = 8;

constexpr size_t MiB = 1u << 20;
constexpr size_t WS_ROWSQ = 0;
constexpr size_t WS_WI = 2 * MiB;
constexpr size_t WS_WAB = 11 * MiB;
constexpr size_t WS_WO = 13 * MiB;
constexpr size_t WS_PW = 15 * MiB;
constexpr size_t WS_H = 16 * MiB;
constexpr size_t WS_PROJ = 80 * MiB;
constexpr size_t WS_AB = 352 * MiB;
constexpr size_t WS_END = 416 * MiB;

__device__ __forceinline__ unsigned f2bf(float f) { unsigned u = __builtin_bit_cast(unsigned, f); return (u + 0x7fffu + ((u >> 16) & 1u)) >> 16; }
__device__ __forceinline__ unsigned pk2(float lo, float hi) { return f2bf(lo) | (f2bf(hi) << 16); }
__device__ __forceinline__ unsigned cvt_pk_bf16(float lo, float hi) { unsigned r; asm volatile("v_cvt_pk_bf16_f32 %0, %1, %2" : "=v"(r) : "v"(lo), "v"(hi)); return r; }
__device__ __forceinline__ float bf_lo(unsigned w) { return __builtin_bit_cast(float, w << 16); }
__device__ __forceinline__ float bf_hi(unsigned w) { return __builtin_bit_cast(float, w & 0xffff0000u); }
__device__ __forceinline__ float sigmoid_den(float g) {
    g = fminf(fmaxf(g, -30.f), 30.f);
    return 1.0f + __builtin_amdgcn_exp2f(-g * LOG2E);
}
__device__ __forceinline__ float silu(float z) { return z * __builtin_amdgcn_rcpf(sigmoid_den(z)); }

namespace pg8 {
constexpr int BM = 256, BK = 64, HALF = 128, HTB = HALF * BK * 2, STAGE_BYTES = 8 * HTB, NXCD = 8, WGM = 8;
__host__ __device__ __forceinline__ int lds_byte(int r, int c) { const int st = (r >> 4) * 2 + (c >> 5), rr = r & 15, cc = c & 31, ob = rr * 64 + cc * 2; return st * 1024 + (ob ^ (((ob >> 9) & 1) << 5)); }
__host__ __device__ __forceinline__ void stage_rc(int b, int& R, int& C) { const int st = b / 1024, sb = b % 1024, swz = sb ^ (((sb >> 9) & 1) << 5); R = (st >> 1) * 16 + swz / 64; C = (st & 1) * 32 + (swz % 64) / 2; }
__host__ __device__ __forceinline__ int perm32(int rho) { const int n = rho >> 4, i = rho & 15; return 8 * (i >> 2) + 4 * n + (i & 3); }

struct Unit { int pm, pn; };
struct Gemm { const bf16_t* A; const bf16_t* Bt; int M, N, K; };

struct StaticOrder {
    int nM, nN, nwg, G, c;
    __device__ void init(int M_, int N_, int G_, int c_) { nM = M_ / BM; nN = N_ / BM; nwg = nM * nN; G = G_; c = c_; }
    __device__ bool next(int i, Unit& u) const {
        const long L = (long)i * G + c; if (L >= nwg) return false;
        int wgid = (int)L; { const int q = nwg / NXCD, r = nwg % NXCD, xcd = wgid % NXCD, off = wgid / NXCD; wgid = (xcd < r ? xcd * (q + 1) : r * (q + 1) + (xcd - r) * q) + off; }
        const int nig = WGM * nN, gid = wgid / nig, fm = gid * WGM, gsz = (nM - fm) < WGM ? (nM - fm) : WGM;
        u.pm = fm + ((wgid % nig) % gsz); u.pn = (wgid % nig) / gsz; return true;
    }
};


struct EpiBf16 {
    static constexpr bool PERM = true, HAS_MID = false;
    bf16_t* O; int ldc;
    __device__ __forceinline__ void mid(f32x4 (&)[2][2][4][2], const Unit&, int, int, int, int) const {}
    __device__ __forceinline__ void operator()(f32x4 (&acc)[2][2][4][2], const Unit& u, int wr, int wc, int fr, int fq) const {
        const int row0 = u.pm * BM + wr * 64 + fr; const int col0 = u.pn * BM + wc * 32 + 8 * fq;
#pragma unroll
        for (int ai = 0; ai < 2; ++ai)
#pragma unroll
            for (int m = 0; m < 4; ++m) { bf16_t* rowp = O + (size_t)(row0 + ai * HALF + m * 16) * ldc + col0;
#pragma unroll
                for (int bj = 0; bj < 2; ++bj) { const f32x4 v0 = acc[ai][bj][m][0], v1 = acc[ai][bj][m][1];
                    u32x4 w; w.x = cvt_pk_bf16(v0[0], v0[1]); w.y = cvt_pk_bf16(v0[2], v0[3]); w.z = cvt_pk_bf16(v1[0], v1[1]); w.w = cvt_pk_bf16(v1[2], v1[3]);
                    *(u32x4*)(rowp + bj * HALF) = w; } }
    }
};

struct EpiMerge {
    static constexpr bool PERM = true, HAS_MID = true;
    const bf16_t* proj; bf16_t* O;
    __device__ __forceinline__ void mid(f32x4 (&acc)[2][2][4][2], const Unit& u, int wr, int wc, int fr, int fq) const {
        int row0 = u.pm * BM + wr * 64 + fr; const int col0 = u.pn * BM + wc * 32 + 8 * fq;
        asm volatile("" : "+v"(row0));
#pragma unroll
        for (int ai = 0; ai < 2; ++ai)
#pragma unroll
            for (int m = 0; m < 4; ++m) { const bf16_t* rowp = proj + (size_t)(row0 + ai * HALF + m * 16) * INW + col0;
#pragma unroll
                for (int bj = 0; bj < 2; ++bj) {
                    const u32x4 ga = *(const u32x4*)(rowp + C_GA + bj * HALF), gb = *(const u32x4*)(rowp + C_GB + bj * HALF);
#pragma unroll
                    for (int j = 0; j < 4; ++j) {
                        const float r0 = sigmoid_den(bf_lo(gb[j])) * __builtin_amdgcn_rcpf(sigmoid_den(bf_lo(ga[j])));
                        const float r1 = sigmoid_den(bf_hi(gb[j])) * __builtin_amdgcn_rcpf(sigmoid_den(bf_hi(ga[j])));
                        acc[ai][bj][m][j >> 1][(j & 1) * 2 + 0] *= r0; acc[ai][bj][m][j >> 1][(j & 1) * 2 + 1] *= r1; } }
                asm volatile("" : "+v"(acc[ai][0][m][0]), "+v"(acc[ai][0][m][1]), "+v"(acc[ai][1][m][0]), "+v"(acc[ai][1][m][1]));
                asm volatile("" ::: "memory"); }
    }
    __device__ __forceinline__ void operator()(f32x4 (&acc)[2][2][4][2], const Unit& u, int wr, int wc, int fr, int fq) const {
        const int row0 = u.pm * BM + wr * 64 + fr; const int col0 = u.pn * BM + wc * 32 + 8 * fq;
#pragma unroll
        for (int ai = 0; ai < 2; ++ai)
#pragma unroll
            for (int m = 0; m < 4; ++m) { const size_t row = (size_t)(row0 + ai * HALF + m * 16);
#pragma unroll
                for (int bj = 0; bj < 2; ++bj) {
                    const u32x4 gb = *(const u32x4*)(proj + row * INW + col0 + C_GB + bj * HALF);
                    float v[8];
#pragma unroll
                    for (int j = 0; j < 4; ++j) {
                        v[2 * j]     = acc[ai][bj][m][j >> 1][(j & 1) * 2 + 0] * __builtin_amdgcn_rcpf(sigmoid_den(bf_lo(gb[j])));
                        v[2 * j + 1] = acc[ai][bj][m][j >> 1][(j & 1) * 2 + 1] * __builtin_amdgcn_rcpf(sigmoid_den(bf_hi(gb[j]))); }
                    u32x4 w; w.x = cvt_pk_bf16(v[0], v[1]); w.y = cvt_pk_bf16(v[2], v[3]); w.z = cvt_pk_bf16(v[4], v[5]); w.w = cvt_pk_bf16(v[6], v[7]);
                    *(u32x4*)(O + row * D + col0 + bj * HALF) = w; }
                asm volatile("" ::: "memory"); }
    }
};

struct EpiOut {
    static constexpr bool PERM = false, HAS_MID = false;
    const float* x; float* out; float* rowsq;
    __device__ __forceinline__ void mid(f32x4 (&)[2][2][4][2], const Unit&, int, int, int, int) const {}
    __device__ __forceinline__ void operator()(f32x4 (&acc)[2][2][4][2], const Unit& u, int wr, int wc, int fr, int fq) const {
        const int row0 = u.pm * BM + wr * 64 + fr; const int col0 = u.pn * BM + wc * 32 + 4 * fq;
#pragma unroll
        for (int ai = 0; ai < 2; ++ai)
#pragma unroll
            for (int m = 0; m < 4; ++m) { const int row = row0 + ai * HALF + m * 16; const size_t off = (size_t)row * D + col0; float s = 0.f;
#pragma unroll
                for (int bj = 0; bj < 2; ++bj)
#pragma unroll
                    for (int n = 0; n < 2; ++n) { const f32x4 xv = *(const f32x4*)(x + off + bj * HALF + n * 16); const f32x4 v = acc[ai][bj][m][n] + xv;
                        s += (v[0] * v[0] + v[1] * v[1]) + (v[2] * v[2] + v[3] * v[3]); *(f32x4*)(out + off + bj * HALF + n * 16) = v; }
                s += __shfl_xor(s, 16); s += __shfl_xor(s, 32);
                if (fq == 0) atomicAdd(rowsq + row, s); }
    }
};

template <class Epi, class Sched, bool ALIGN_EPI = false, bool SP2 = false>
__device__ __forceinline__ void gemm_phase(LAS unsigned char* lds, const Gemm g, const Sched& S, const Epi& E) {
    const int tid = threadIdx.x, wid = __builtin_amdgcn_readfirstlane(tid >> 6), lane = tid & 63, wr = wid >> 2, wc = wid & 3, fr = lane & 15, fq = lane >> 4;
    const int K = g.K, nt = K / BK;
    unsigned voffA[2], voffB[2];
#pragma unroll
    for (int i = 0; i < 2; ++i) { int R, C; stage_rc(tid * 16 + i * 8192, R, C); const int Rb = Epi::PERM ? ((R & ~31) + perm32(R & 31)) : R;
        voffA[i] = (unsigned)(R * K + C) * 2u; voffB[i] = (unsigned)(Rb * K + C) * 2u; }
    const size_t kstep = (size_t)(BK * 2);
    const size_t hstep = (size_t)HALF * K * 2;
    const size_t tstep = 2 * hstep;
    const unsigned ldsw = (unsigned)wid * 1024u;
    const int aoff = lds_byte(wr * 64 + fr, fq * 8), boff = lds_byte(wc * 32 + fr, fq * 8);
#define PG8_SA(b, h) (((b) * 2 + (h)) * HTB)
#define PG8_SB(b, h) ((4 + (b) * 2 + (h)) * HTB)
#define PG8_STAGE(bufoff, gbase, voff) do { _Pragma("unroll") for (int _i = 0; _i < 2; ++_i) \
        __builtin_amdgcn_global_load_lds((const unsigned*)((const char*)(gbase) + (voff)[_i]), (LAS unsigned*)(lds + (bufoff) + ldsw + _i * 8192), 16, 0, 0); } while (0)
#define PG8_LDA(dst, b, h) do { _Pragma("unroll") for (int m = 0; m < 4; ++m) _Pragma("unroll") for (int k = 0; k < 2; ++k) dst[m][k] = *(const LAS bf16x8*)(lds + PG8_SA(b, h) + aoff + m * 2048 + k * 1024); } while (0)
#define PG8_LDB(dst, b, h) do { _Pragma("unroll") for (int n = 0; n < 2; ++n) _Pragma("unroll") for (int k = 0; k < 2; ++k) dst[n][k] = *(const LAS bf16x8*)(lds + PG8_SB(b, h) + boff + n * 2048 + k * 1024); } while (0)
#define PG8_MMA(ai, bj, At, Bt) do { __builtin_amdgcn_s_setprio(1); _Pragma("unroll") for (int m = 0; m < 4; ++m) _Pragma("unroll") for (int n = 0; n < 2; ++n) _Pragma("unroll") for (int k = 0; k < 2; ++k) \
        acc[ai][bj][m][n] = __builtin_amdgcn_mfma_f32_16x16x32_bf16(Bt[n][k], At[m][k], acc[ai][bj][m][n], 0, 0, 0); __builtin_amdgcn_s_setprio(0); } while (0)
#define PG8_WAIT_V(n) asm volatile("s_waitcnt vmcnt(" #n ")" ::: "memory")
#define PG8_WAIT_L(n) asm volatile("s_waitcnt lgkmcnt(" #n ")" ::: "memory")
#define PG8_BAR __builtin_amdgcn_s_barrier()
#define PG8_SCHED __builtin_amdgcn_sched_barrier(0)
    Unit cur, nxt; int ui = 0;
    if (!S.next(0, cur)) return;
    f32x4 acc[2][2][4][2];
#pragma unroll
    for (int a = 0; a < 2; ++a)
#pragma unroll
        for (int b = 0; b < 2; ++b)
#pragma unroll
            for (int m = 0; m < 4; ++m)
#pragma unroll
                for (int n = 0; n < 2; ++n) acc[a][b][m][n] = (f32x4){0.f, 0.f, 0.f, 0.f};
    bf16x8 At[4][2], B0[2][2], B1[2][2];
    const char* cA = (const char*)g.A + (size_t)cur.pm * tstep; const char* cB = (const char*)g.Bt + (size_t)cur.pn * tstep;
    if constexpr (SP2) {
        PG8_STAGE(PG8_SB(0, 0), cB, voffB); PG8_STAGE(PG8_SB(0, 1), cB + hstep, voffB); PG8_STAGE(PG8_SA(0, 0), cA, voffA); PG8_STAGE(PG8_SA(0, 1), cA + hstep, voffA);
        if (wr == 1) PG8_BAR;
        PG8_WAIT_V(2); PG8_BAR;
        PG8_STAGE(PG8_SB(1, 0), cB + kstep, voffB); PG8_STAGE(PG8_SA(1, 0), cA + kstep, voffA); PG8_STAGE(PG8_SB(1, 1), cB + hstep + kstep, voffB);
        PG8_WAIT_V(6); PG8_BAR;
    } else {
        PG8_STAGE(PG8_SB(0, 0), cB, voffB); PG8_STAGE(PG8_SA(0, 0), cA, voffA); PG8_STAGE(PG8_SB(0, 1), cB + hstep, voffB); PG8_STAGE(PG8_SA(0, 1), cA + hstep, voffA);
        if (wr == 1) PG8_BAR;
        PG8_WAIT_V(4); PG8_BAR;
        PG8_STAGE(PG8_SB(1, 0), cB + kstep, voffB); PG8_STAGE(PG8_SA(1, 0), cA + kstep, voffA); PG8_STAGE(PG8_SB(1, 1), cB + hstep + kstep, voffB);
        PG8_WAIT_V(6); PG8_BAR;
    }
    for (;;) {
        const bool has_next = S.next(ui + 1, nxt);
        const char* nA = has_next ? (const char*)g.A + (size_t)nxt.pm * tstep : cA; const char* nB = has_next ? (const char*)g.Bt + (size_t)nxt.pn * tstep : cB;
        for (int t = 0; t < nt; t += 2) {
            const bool last = (t == nt - 2);
            const char* a1 = cA + (size_t)(t + 1) * kstep;
            const char* a2 = last ? nA : cA + (size_t)(t + 2) * kstep; const char* b2 = last ? nB : cB + (size_t)(t + 2) * kstep;
            const char* a3 = a2 + kstep; const char* b3 = b2 + kstep;
            if constexpr (SP2) {
            PG8_LDB(B0, 0, 0); PG8_LDB(B1, 0, 1); PG8_SCHED; PG8_LDA(At, 0, 0); PG8_STAGE(PG8_SA(1, 1), a1 + hstep, voffA);
            PG8_WAIT_V(8); PG8_WAIT_L(0); PG8_BAR; PG8_MMA(0, 0, At, B0); PG8_MMA(0, 1, At, B1); PG8_BAR; PG8_SCHED;
            PG8_LDA(At, 0, 1); PG8_STAGE(PG8_SB(0, 0), b2, voffB); PG8_STAGE(PG8_SB(0, 1), b2 + hstep, voffB); PG8_STAGE(PG8_SA(0, 0), a2, voffA);
            PG8_WAIT_V(8); PG8_WAIT_L(0); PG8_BAR; PG8_MMA(1, 0, At, B0); PG8_MMA(1, 1, At, B1); PG8_BAR; PG8_SCHED;
            PG8_LDB(B0, 1, 0); PG8_LDB(B1, 1, 1); PG8_SCHED; PG8_LDA(At, 1, 0); PG8_STAGE(PG8_SA(0, 1), a2 + hstep, voffA);
            PG8_WAIT_V(8); PG8_WAIT_L(0); PG8_BAR; PG8_MMA(0, 0, At, B0); PG8_MMA(0, 1, At, B1); PG8_BAR; PG8_SCHED;
            PG8_LDA(At, 1, 1); PG8_STAGE(PG8_SB(1, 0), b3, voffB); PG8_STAGE(PG8_SB(1, 1), b3 + hstep, voffB); PG8_STAGE(PG8_SA(1, 0), a3, voffA);
            PG8_WAIT_V(8); PG8_WAIT_L(0); PG8_BAR; PG8_MMA(1, 0, At, B0); PG8_MMA(1, 1, At, B1); PG8_BAR; PG8_SCHED;
            } else {
            PG8_LDB(B0, 0, 0); PG8_SCHED; PG8_LDA(At, 0, 0); PG8_STAGE(PG8_SA(1, 1), a1 + hstep, voffA);
            PG8_WAIT_L(8); PG8_BAR; PG8_WAIT_L(0); PG8_MMA(0, 0, At, B0); PG8_BAR; PG8_SCHED;
            PG8_LDB(B1, 0, 1); PG8_STAGE(PG8_SB(0, 0), b2, voffB);
            PG8_BAR; PG8_WAIT_L(0); PG8_MMA(0, 1, At, B1); PG8_BAR;
            PG8_LDA(At, 0, 1); PG8_STAGE(PG8_SA(0, 0), a2, voffA);
            PG8_BAR; PG8_WAIT_L(0); PG8_MMA(1, 0, At, B0); PG8_BAR; PG8_SCHED;
            PG8_STAGE(PG8_SB(0, 1), b2 + hstep, voffB);
            PG8_WAIT_V(6); PG8_BAR; PG8_MMA(1, 1, At, B1); PG8_BAR;
            PG8_LDB(B0, 1, 0); PG8_SCHED; PG8_LDA(At, 1, 0); PG8_STAGE(PG8_SA(0, 1), a2 + hstep, voffA);
            PG8_WAIT_L(8); PG8_BAR; PG8_WAIT_L(0); PG8_MMA(0, 0, At, B0); PG8_BAR; PG8_SCHED;
            PG8_LDB(B1, 1, 1); PG8_STAGE(PG8_SB(1, 0), b3, voffB);
            PG8_BAR; PG8_WAIT_L(0); PG8_MMA(0, 1, At, B1); PG8_BAR;
            PG8_LDA(At, 1, 1); PG8_STAGE(PG8_SA(1, 0), a3, voffA);
            PG8_BAR; PG8_WAIT_L(0); PG8_MMA(1, 0, At, B0); PG8_BAR; PG8_SCHED;
            PG8_STAGE(PG8_SB(1, 1), b3 + hstep, voffB);
            PG8_WAIT_V(6); PG8_BAR; PG8_MMA(1, 1, At, B1); PG8_BAR;
            }
            if constexpr (Epi::HAS_MID) { if (t == nt / 2 - 2) { asm volatile("" ::: "memory"); E.mid(acc, cur, wr, wc, fr, fq); asm volatile("" ::: "memory"); } }
        }
        if constexpr (ALIGN_EPI) { if (wr == 0) PG8_BAR; }
        E(acc, cur, wr, wc, fr, fq);
        if (!has_next) break;
#pragma unroll
        for (int a = 0; a < 2; ++a)
#pragma unroll
            for (int b = 0; b < 2; ++b)
#pragma unroll
                for (int m = 0; m < 4; ++m)
#pragma unroll
                    for (int n = 0; n < 2; ++n) acc[a][b][m][n] = (f32x4){0.f, 0.f, 0.f, 0.f};
        cur = nxt; cA = nA; cB = nB; ++ui;
        if constexpr (ALIGN_EPI) { if (wr == 1) PG8_BAR; }
    }
    PG8_WAIT_V(0);
    if constexpr (!ALIGN_EPI) { if (wr == 0) PG8_BAR; }
    PG8_BAR;
#undef PG8_SA
#undef PG8_SB
#undef PG8_STAGE
#undef PG8_LDA
#undef PG8_LDB
#undef PG8_MMA
#undef PG8_WAIT_V
#undef PG8_WAIT_L
#undef PG8_BAR
#undef PG8_SCHED
}
}

constexpr int RING_BYTES = 131072;
constexpr int LDS_BYTES = 147456;

__device__ __forceinline__ float wave_sum(float v) {
#pragma unroll
    for (int o = 1; o < 64; o <<= 1) v += __shfl_xor(v, o);
    return v;
}
__device__ __forceinline__ void p0_transpose_item(const float* W, int ldn, int k0, int n0, bf16_t* WT, int ldk, int kdst0, float scale, LAS float* scr, int lane) {
#pragma unroll 8
    for (int i = 0; i < 32; ++i) { const int kk = 2 * i + (lane >> 5); scr[kk * 33 + (lane & 31)] = W[(size_t)(k0 + kk) * ldn + n0 + (lane & 31)] * scale; }
    asm volatile("s_waitcnt lgkmcnt(0)" ::: "memory");
    const int c = lane & 7;
#pragma unroll
    for (int j = 0; j < 4; ++j) { const int n = (lane >> 3) + 8 * j; const LAS float* s = scr + (8 * c) * 33 + n;
        u32x4 o; o.x = pk2(s[0 * 33], s[1 * 33]); o.y = pk2(s[2 * 33], s[3 * 33]); o.z = pk2(s[4 * 33], s[5 * 33]); o.w = pk2(s[6 * 33], s[7 * 33]);
        *(u32x4*)(WT + (size_t)(n0 + n) * ldk + kdst0 + k0 + 8 * c) = o; }
    asm volatile("s_waitcnt lgkmcnt(0)" ::: "memory");
}

struct Ptrs {
    const float *x, *norm_g, *w_in, *sink, *pool_w, *pool_scale, *w_a, *w_b, *w_out, *fin_g;
    float* out; float* rowsq;
    bf16_t *Wi, *Wab, *Wo, *Pw, *H, *PROJ, *AB;
};

__device__ __forceinline__ void p0_prologue(const Ptrs& P, LAS unsigned char* lds, int vcu, int G, int wave, int lane) {
    LAS float* scr = (LAS float*)(lds + wave * 16384);
    const int gw = vcu * NWAVES + wave, NGW = G * NWAVES;
    constexpr int I_IN = (D / 64) * (INW / 32), I_A = (512 / 64) * (D / 32), I_O = (D / 64) * (D / 32), I_P = 4 * 2 * 4;
    constexpr int NITEMS = I_IN + 2 * I_A + I_O + I_P;
    for (int it = gw; it < NITEMS; it += NGW) {
        int r = it;
        if (r < I_IN) { const int nblk = INW / 32, kb = r / nblk, nb = r % nblk; p0_transpose_item(P.w_in, INW, 64 * kb, 32 * nb, P.Wi, D, 0, (32 * nb < 512) ? QSCALE2 : 1.0f, scr, lane); continue; } r -= I_IN;
        if (r < I_A) { const int nblk = D / 32, kb = r / nblk, nb = r % nblk; p0_transpose_item(P.w_a, D, 64 * kb, 32 * nb, P.Wab, D, 0, 1.0f, scr, lane); continue; } r -= I_A;
        if (r < I_A) { const int nblk = D / 32, kb = r / nblk, nb = r % nblk; p0_transpose_item(P.w_b, D, 64 * kb, 32 * nb, P.Wab, D, 512, 1.0f, scr, lane); continue; } r -= I_A;
        if (r < I_O) { const int nblk = D / 32, kb = r / nblk, nb = r % nblk; p0_transpose_item(P.w_out, D, 64 * kb, 32 * nb, P.Wo, D, 0, 1.0f, scr, lane); continue; } r -= I_O;
        { const int g = r / 8, q = r % 8, kb = q / 4, nb = q % 4; p0_transpose_item(P.pool_w + (size_t)g * 128 * 128, 128, 64 * kb, 32 * nb, P.Pw + (size_t)g * 128 * 128, 128, 0, 1.0f, scr, lane); }
    }
    f32x4 gv[4];
#pragma unroll
    for (int j = 0; j < 4; ++j) gv[j] = *((const f32x4*)P.norm_g + lane + 64 * j);
    for (int m = gw; m < M; m += NGW) {
        const f32x4* xr = (const f32x4*)(P.x + (size_t)m * D) + lane;
        f32x4 v[4]; float s = 0.f;
#pragma unroll
        for (int j = 0; j < 4; ++j) { v[j] = xr[64 * j]; s += (v[j].x * v[j].x + v[j].y * v[j].y) + (v[j].z * v[j].z + v[j].w * v[j].w); }
        const float rs = 1.0f / sqrtf(wave_sum(s) * (1.f / D) + EPS);
        unsigned long long* o8 = (unsigned long long*)(P.H + (size_t)m * D) + lane;
#pragma unroll
        for (int j = 0; j < 4; ++j) { const f32x4 h = v[j] * rs * gv[j]; o8[64 * j] = (unsigned long long)pk2(h.x, h.y) | ((unsigned long long)pk2(h.z, h.w) << 32); }
    }
    for (int i = gw * 64 + lane; i < M; i += NGW * 64) P.rowsq[i] = 0.f;
}

namespace att {
constexpr int LDS_K = 0, LDS_V = 384 * 128;
__device__ __forceinline__ int crow(int r, int hi) { return (r & 3) + 8 * (r >> 2) + 4 * hi; }
__device__ __forceinline__ float swap_max(float v) { auto rr = __builtin_amdgcn_permlane32_swap(__float_as_uint(v), __float_as_uint(v), false, false); return fmaxf(__uint_as_float(rr[0]), __uint_as_float(rr[1])); }
__device__ __forceinline__ float swap_sum(float v) { auto rr = __builtin_amdgcn_permlane32_swap(__float_as_uint(v), __float_as_uint(v), false, false); return __uint_as_float(rr[0]) + __uint_as_float(rr[1]); }
__device__ __forceinline__ s16x4 vtr(const LAS unsigned char* p) { return __builtin_bit_cast(s16x4, __builtin_amdgcn_ds_read_tr16_b64_v4i16((LAS s16x4*)p)); }

__device__ __forceinline__ void attn_unit(LAS unsigned char* lds, const bf16_t* proj, bf16_t* AB, const float* sink, int b, int nb, int hk) {
    const int tid = threadIdx.x, lane = tid & 63, wid = __builtin_amdgcn_readfirstlane(tid >> 6);
    const int t0 = nb * 128; const size_t rowbase = (size_t)b * SEQ;
#pragma unroll
    for (int i = 0; i < 6; ++i) {
        const int row = (tid >> 3) + 64 * i, ch = tid & 7, s = t0 - 128 + row;
        if (s >= 0 && s < SEQ) {
            const bf16_t* src = proj + (rowbase + s) * INW + C_K + hk * 64 + ch * 8;
            const u32x4 kv = *(const u32x4*)src, vv = *(const u32x4*)(src + (C_V - C_K));
            *(LAS u32x4*)(lds + LDS_K + row * 128 + ((ch ^ ((row >> 1) & 7)) << 4)) = kv;
            *(LAS u32x4*)(lds + LDS_V + row * 128 + ((ch ^ (((row >> 1) & 1) << 2)) << 4)) = vv;
        }
    }
    __syncthreads();
    const int g = wid & 3, rh = wid >> 2, hq = hk * 4 + g;
    const int q = lane & 31, hi = lane >> 5;
    const float slope2 = __builtin_amdgcn_exp2f(-(float)(hq + 1)) * LOG2E;
    const float sink2 = sink[hq] * LOG2E;
    int koff[4];
#pragma unroll
    for (int ks = 0; ks < 4; ++ks) koff[ks] = LDS_K + q * 128 + (((2 * ks + hi) ^ ((q >> 1) & 7)) << 4);
    const int i16 = lane & 15, qd = i16 >> 2, pp = i16 & 3, g1 = (lane >> 4) & 1;
    int vbase[2];
#pragma unroll
    for (int db = 0; db < 2; ++db) vbase[db] = LDS_V + (4 * hi + qd) * 128 + ((32 * g1 + 8 * pp + 64 * db) ^ (((qd >> 1) & 1) << 6));
#pragma unroll 1
    for (int sbi = 0; sbi < 2; ++sbi) {
        const int sb = 2 * rh + sbi;
        const int tq = t0 + 32 * sb + q;
        const bf16_t* qp = proj + (rowbase + tq) * INW + C_Q + hq * 64 + hi * 8;
        bf16x8 qr[4];
#pragma unroll
        for (int ks = 0; ks < 4; ++ks) qr[ks] = *(const bf16x8*)(qp + 16 * ks);
        float mrun = sink2, l = (hi == 0) ? 1.0f : 0.0f;
        f32x16 o0, o1;
#pragma unroll
        for (int r = 0; r < 16; ++r) { o0[r] = 0.f; o1[r] = 0.f; }
#pragma unroll 1
        for (int c = 0; c < 9; ++c) {
            const int cb = 32 * (sb + c);
            const int s0 = t0 - 128 + cb;
            if (s0 < 0 || s0 >= SEQ) continue;
            const LAS unsigned char* kb = lds + cb * 128;
            f32x16 p;
#pragma unroll
            for (int r = 0; r < 16; ++r) p[r] = 0.f;
#pragma unroll
            for (int ks = 0; ks < 4; ++ks) { const bf16x8 kf = *(const LAS bf16x8*)(kb + koff[ks]); p = __builtin_amdgcn_mfma_f32_32x32x16_bf16(kf, qr[ks], p, 0, 0, 0); }
            const int dbase = q + 128 - 32 * c - 4 * hi;
            float rm = -1e30f;
#pragma unroll
            for (int r = 0; r < 16; ++r) { const float dist = fabsf((float)(dbase - ((r & 3) + 8 * (r >> 2))));
                float sc = p[r] - slope2 * dist; sc = (dist <= 128.0f) ? sc : -1e30f; p[r] = sc; rm = fmaxf(rm, sc); }
            rm = swap_max(rm);
            const float mn = fmaxf(mrun, rm); const float alpha = __builtin_amdgcn_exp2f(mrun - mn); mrun = mn;
            float ps = 0.f;
#pragma unroll
            for (int r = 0; r < 16; ++r) { p[r] = __builtin_amdgcn_exp2f(p[r] - mn); ps += p[r]; }
            l = l * alpha + ps;
            if (__builtin_amdgcn_ballot_w64(alpha != 1.0f) != 0ull) {
#pragma unroll
                for (int r = 0; r < 16; ++r) { o0[r] *= alpha; o1[r] *= alpha; } }
            u32x4 w0, w1;
            w0.x = cvt_pk_bf16(p[0], p[1]); w0.y = cvt_pk_bf16(p[2], p[3]); w0.z = cvt_pk_bf16(p[4], p[5]); w0.w = cvt_pk_bf16(p[6], p[7]);
            w1.x = cvt_pk_bf16(p[8], p[9]); w1.y = cvt_pk_bf16(p[10], p[11]); w1.z = cvt_pk_bf16(p[12], p[13]); w1.w = cvt_pk_bf16(p[14], p[15]);
            const bf16x8 pb0 = __builtin_bit_cast(bf16x8, w0), pb1 = __builtin_bit_cast(bf16x8, w1);
            const LAS unsigned char* vb0 = lds + cb * 128 + vbase[0]; const LAS unsigned char* vb1 = lds + cb * 128 + vbase[1];
            { const s16x4 a = vtr(vb0), bq = vtr(vb0 + 8 * 128); const bf16x8 va = (bf16x8){a[0], a[1], a[2], a[3], bq[0], bq[1], bq[2], bq[3]};
              o0 = __builtin_amdgcn_mfma_f32_32x32x16_bf16(va, pb0, o0, 0, 0, 0); }
            { const s16x4 a = vtr(vb0 + 16 * 128), bq = vtr(vb0 + 24 * 128); const bf16x8 va = (bf16x8){a[0], a[1], a[2], a[3], bq[0], bq[1], bq[2], bq[3]};
              o0 = __builtin_amdgcn_mfma_f32_32x32x16_bf16(va, pb1, o0, 0, 0, 0); }
            { const s16x4 a = vtr(vb1), bq = vtr(vb1 + 8 * 128); const bf16x8 va = (bf16x8){a[0], a[1], a[2], a[3], bq[0], bq[1], bq[2], bq[3]};
              o1 = __builtin_amdgcn_mfma_f32_32x32x16_bf16(va, pb0, o1, 0, 0, 0); }
            { const s16x4 a = vtr(vb1 + 16 * 128), bq = vtr(vb1 + 24 * 128); const bf16x8 va = (bf16x8){a[0], a[1], a[2], a[3], bq[0], bq[1], bq[2], bq[3]};
              o1 = __builtin_amdgcn_mfma_f32_32x32x16_bf16(va, pb1, o1, 0, 0, 0); }
        }
        l = swap_sum(l);
        const float inv = 1.0f / l;
        const bf16_t* zp = proj + (rowbase + tq) * INW + C_ZA + hq * 64 + 4 * hi;
        bf16_t* op = AB + (rowbase + tq) * D + hq * 64 + 4 * hi;
#pragma unroll
        for (int k4 = 0; k4 < 4; ++k4) {
            { const u32x2 z = *(const u32x2*)(zp + 8 * k4);
              const float v0 = o0[4 * k4 + 0] * inv * silu(bf_lo(z.x)), v1 = o0[4 * k4 + 1] * inv * silu(bf_hi(z.x)), v2 = o0[4 * k4 + 2] * inv * silu(bf_lo(z.y)), v3 = o0[4 * k4 + 3] * inv * silu(bf_hi(z.y));
              u32x2 w; w.x = cvt_pk_bf16(v0, v1); w.y = cvt_pk_bf16(v2, v3); *(u32x2*)(op + 8 * k4) = w; }
            { const u32x2 z = *(const u32x2*)(zp + 32 + 8 * k4);
              const float v0 = o1[4 * k4 + 0] * inv * silu(bf_lo(z.x)), v1 = o1[4 * k4 + 1] * inv * silu(bf_hi(z.x)), v2 = o1[4 * k4 + 2] * inv * silu(bf_lo(z.y)), v3 = o1[4 * k4 + 3] * inv * silu(bf_hi(z.y));
              u32x2 w; w.x = cvt_pk_bf16(v0, v1); w.y = cvt_pk_bf16(v2, v3); *(u32x2*)(op + 32 + 8 * k4) = w; }
        }
    }
    __syncthreads();
}
}

namespace pool {
template <int W> __device__ __forceinline__ void pool_rows(LAS unsigned char* lds, const Ptrs& P, int m0, int g, int wid, int lane) {
    const int row = lane & 31, hi = lane >> 5;
    const int m = m0 + 32 * wid + row, t = m & (SEQ - 1);
    const int lo = (t - W / 2) < 0 ? 0 : (t - W / 2), hb = (t + W / 2) > SEQ ? SEQ : (t + W / 2);
    const float inv = 1.0f / (float)(hb - lo);
    const int rc = 8 + 32 * wid + row;
    f32x16 acc[4];
#pragma unroll
    for (int db = 0; db < 4; ++db)
#pragma unroll
        for (int r = 0; r < 16; ++r) acc[db][r] = 0.f;
    const bf16_t* pw = P.Pw + ((size_t)g * 128 + row) * 128 + 8 * hi;
#pragma unroll 2
    for (int ks = 0; ks < 8; ++ks) {
        const int ch = 2 * ks + hi;
        float sum[8], self[8];
#pragma unroll
        for (int j = 0; j < 8; ++j) { sum[j] = 0.f; self[j] = 0.f; }
#pragma unroll
        for (int o = -W / 2; o < W / 2; ++o) {
            const int rr = rc + o; const bool ok = (t + o >= 0) && (t + o < SEQ);
            const u32x4 v = *(const LAS u32x4*)(lds + rr * 256 + ((ch ^ (rr & 15)) << 4));
            float f[8];
#pragma unroll
            for (int j = 0; j < 4; ++j) { f[2 * j] = bf_lo(v[j]); f[2 * j + 1] = bf_hi(v[j]); }
#pragma unroll
            for (int j = 0; j < 8; ++j) { sum[j] += ok ? f[j] : 0.f; if (o == 0) self[j] = f[j]; }
        }
        u32x4 w;
        w.x = cvt_pk_bf16(sum[0] * inv - self[0], sum[1] * inv - self[1]); w.y = cvt_pk_bf16(sum[2] * inv - self[2], sum[3] * inv - self[3]);
        w.z = cvt_pk_bf16(sum[4] * inv - self[4], sum[5] * inv - self[5]); w.w = cvt_pk_bf16(sum[6] * inv - self[6], sum[7] * inv - self[7]);
        const bf16x8 pk = __builtin_bit_cast(bf16x8, w);
#pragma unroll
        for (int db = 0; db < 4; ++db) { const bf16x8 a = *(const bf16x8*)(pw + (size_t)db * 32 * 128 + 16 * ks); acc[db] = __builtin_amdgcn_mfma_f32_32x32x16_bf16(a, pk, acc[db], 0, 0, 0); }
    }
    const bf16_t* zp = P.PROJ + (size_t)m * INW + C_ZB + g * 128 + 4 * hi;
    const float* sp = P.pool_scale + g * 128 + 4 * hi;
    bf16_t* op = P.AB + (size_t)m * D + 512 + g * 128 + 4 * hi;
#pragma unroll
    for (int db = 0; db < 4; ++db)
#pragma unroll
        for (int k4 = 0; k4 < 4; ++k4) { const int d = 32 * db + 8 * k4;
            const u32x2 z = *(const u32x2*)(zp + d); const f32x4 sc = *(const f32x4*)(sp + d);
            const float v0 = acc[db][4 * k4 + 0] * sc[0] * silu(bf_lo(z.x)), v1 = acc[db][4 * k4 + 1] * sc[1] * silu(bf_hi(z.x));
            const float v2 = acc[db][4 * k4 + 2] * sc[2] * silu(bf_lo(z.y)), v3 = acc[db][4 * k4 + 3] * sc[3] * silu(bf_hi(z.y));
            u32x2 w; w.x = cvt_pk_bf16(v0, v1); w.y = cvt_pk_bf16(v2, v3); *(u32x2*)(op + d) = w; }
}
__device__ __forceinline__ void pool_unit(LAS unsigned char* lds, const Ptrs& P, int tile, int g) {
    const int tid = threadIdx.x, lane = tid & 63, wid = __builtin_amdgcn_readfirstlane(tid >> 6);
    const int m0 = tile * 256;
    for (int i = tid; i < 272 * 16; i += NWAVES * 64) {
        const int rr = i >> 4, ch = i & 15; int mm = m0 - 8 + rr; mm = mm < 0 ? 0 : (mm > M - 1 ? M - 1 : mm);
        const u32x4 v = *(const u32x4*)(P.PROJ + (size_t)mm * INW + C_UB + g * 128 + ch * 8);
        *(LAS u32x4*)(lds + rr * 256 + ((ch ^ (rr & 15)) << 4)) = v;
    }
    __syncthreads();
    if (g == 0) pool_rows<2>(lds, P, m0, g, wid, lane);
    else if (g == 1) pool_rows<4>(lds, P, m0, g, wid, lane);
    else if (g == 2) pool_rows<8>(lds, P, m0, g, wid, lane);
    else pool_rows<16>(lds, P, m0, g, wid, lane);
    __syncthreads();
}
}

struct Args { const float* in[10]; float* out; unsigned char* ws; int ph_lo, ph_hi; };
constexpr int N_PHASES = 6;

__global__ void __launch_bounds__(NWAVES * 64, 2) fwd_megakernel(Args args) {
    extern __shared__ __attribute__((aligned(16))) unsigned char lds_raw[];
    LAS unsigned char* lds = (LAS unsigned char*)lds_raw;
    cg::grid_group grid = cg::this_grid();
    const int tid = threadIdx.x, lane = tid & 63, wave = __builtin_amdgcn_readfirstlane(tid >> 6);
    const int G = gridDim.x, bx = blockIdx.x;
    const int vcu = (G % 8 == 0) ? (bx % 8) * (G / 8) + bx / 8 : bx;
    Ptrs P;
    P.x = args.in[0]; P.norm_g = args.in[1]; P.w_in = args.in[2]; P.sink = args.in[3]; P.pool_w = args.in[4]; P.pool_scale = args.in[5];
    P.w_a = args.in[6]; P.w_b = args.in[7]; P.w_out = args.in[8]; P.fin_g = args.in[9]; P.out = args.out;
    unsigned char* ws = args.ws;
    P.rowsq = (float*)(ws + WS_ROWSQ); P.Wi = (bf16_t*)(ws + WS_WI); P.Wab = (bf16_t*)(ws + WS_WAB); P.Wo = (bf16_t*)(ws + WS_WO); P.Pw = (bf16_t*)(ws + WS_PW);
    P.H = (bf16_t*)(ws + WS_H); P.PROJ = (bf16_t*)(ws + WS_PROJ); P.AB = (bf16_t*)(ws + WS_AB);
    const int lo = args.ph_lo, hi = args.ph_hi;
#ifndef PHASE_MASK
#define PHASE_MASK 63
#endif
#define IN(k) (((PHASE_MASK >> (k)) & 1) && lo <= (k) && (k) < hi)
#define BOTH(k) (IN(k) && IN((k) + 1))

    if (IN(0)) { p0_prologue(P, lds, vcu, G, wave, lane); if (BOTH(0)) grid.sync(); }

    if (IN(1)) {
        pg8::Gemm g{P.H, P.Wi, M, INW, D}; pg8::StaticOrder S; S.init(M, INW, G, bx);
        pg8::EpiBf16 E{P.PROJ, INW};
        pg8::gemm_phase<pg8::EpiBf16, pg8::StaticOrder, true, true>(lds, g, S, E);
        if (BOTH(1)) grid.sync();
    }

    if (IN(2)) {
        for (int u = vcu; u < BATCH * 64 * 2; u += G) { const int hk = u & 1, nb = (u >> 1) & 63, b = u >> 7; att::attn_unit(lds, P.PROJ, P.AB, P.sink, b, nb, hk); }
        for (int u = vcu; u < (M / 256) * 4; u += G) { const int g = u & 3, tile = u >> 2; pool::pool_unit(lds, P, tile, g); }
        if (BOTH(2)) grid.sync();
    }

    if (IN(3)) {
        pg8::Gemm g{P.AB, P.Wab, M, D, D}; pg8::StaticOrder S; S.init(M, D, G, bx);
        pg8::EpiMerge E{P.PROJ, P.H};
        pg8::gemm_phase<pg8::EpiMerge, pg8::StaticOrder, true, true>(lds, g, S, E);
        if (BOTH(3)) grid.sync();
    }

    if (IN(4)) {
        pg8::Gemm g{P.H, P.Wo, M, D, D}; pg8::StaticOrder S; S.init(M, D, G, bx);
        pg8::EpiOut E{P.x, P.out, P.rowsq};
        pg8::gemm_phase<pg8::EpiOut, pg8::StaticOrder, true, true>(lds, g, S, E);
        if (BOTH(4)) grid.sync();
    }

    if (IN(5)) {
        const int gw = vcu * NWAVES + wave, NGW = G * NWAVES;
        f32x4 gv[4];
#pragma unroll
        for (int j = 0; j < 4; ++j) gv[j] = *((const f32x4*)P.fin_g + lane + 64 * j);
        for (int m = gw; m < M; m += NGW) {
            f32x4* xr = (f32x4*)(P.out + (size_t)m * D) + lane;
            const float rs = 1.0f / sqrtf(P.rowsq[m] * (1.f / D) + EPS);
#pragma unroll
            for (int j = 0; j < 4; ++j) { const f32x4 v = xr[64 * j]; xr[64 * j] = v * rs * gv[j]; }
        }
    }
#undef IN
#undef BOTH
}

#ifndef MK_N_LAUNCHES
#define MK_N_LAUNCHES 1
#endif
extern "C" void kernel_launch(void* const* d_in, const int* in_sizes, int n_in, void* d_out, int out_size, void* d_ws, size_t ws_size, hipStream_t stream) {
    static int grid = 0;
    if (grid == 0) {
        if (n_in != 10 || in_sizes[0] != M * D || out_size != M * D || ws_size < WS_END) { fprintf(stderr, "kernel_launch: unexpected shapes / workspace (n_in %d, in0 %d, out %d, ws %zu)\n", n_in, n_in > 0 ? in_sizes[0] : -1, out_size, ws_size); grid = -1; return; }
        int dev = 0, cus = 0, per_cu = 0;
        if (hipGetDevice(&dev) != hipSuccess || hipDeviceGetAttribute(&cus, hipDeviceAttributeMultiprocessorCount, dev) != hipSuccess) { grid = -1; return; }
        if (hipFuncSetAttribute((const void*)fwd_megakernel, hipFuncAttributeMaxDynamicSharedMemorySize, LDS_BYTES) != hipSuccess) { fprintf(stderr, "kernel_launch: hipFuncSetAttribute failed\n"); grid = -1; return; }
        if (hipOccupancyMaxActiveBlocksPerMultiprocessor(&per_cu, (const void*)fwd_megakernel, NWAVES * 64, LDS_BYTES) != hipSuccess || per_cu < 1) { fprintf(stderr, "kernel_launch: occupancy query says %d blocks per CU\n", per_cu); (void)hipGetLastError(); per_cu = 1; }
        grid = cus * 1;
    }
    if (grid < 0) return;
    Args a{};
    for (int i = 0; i < 10; ++i) a.in[i] = (const float*)d_in[i];
    a.out = (float*)d_out; a.ws = (unsigned char*)d_ws;
#if MK_N_LAUNCHES == 1
    a.ph_lo = 0; a.ph_hi = N_PHASES;
    void* kargs[] = {&a};
    hipError_t e = hipLaunchCooperativeKernel((const void*)fwd_megakernel, dim3(grid), dim3(NWAVES * 64), kargs, LDS_BYTES, stream);
    if (e != hipSuccess) fprintf(stderr, "kernel_launch: cooperative launch failed: %s (grid %d)\n", hipGetErrorString(e), grid);
#else
    for (int li = 0; li < N_PHASES; ++li) { a.ph_lo = li; a.ph_hi = li + 1; hipLaunchKernelGGL(fwd_megakernel, dim3(grid), dim3(NWAVES * 64), LDS_BYTES, stream, a); }
#endif
}
```

```cpp
#include <hip/hip_runtime.h>
#include <hip/hip_cooperative_groups.h>
#include <cstdio>
#include <cstdint>
namespace cg = cooperative_groups;

#define LAS __attribute__((address_space(3)))
typedef unsigned short bf16_t;
typedef short bf16x8 __attribute__((ext_vector_type(8)));
typedef short s16x4 __attribute__((ext_vector_type(4)));
typedef float f32x4 __attribute__((ext_vector_type(4)));
typedef float f32x16 __attribute__((ext_vector_type(16)));
typedef unsigned u32x4 __attribute__((ext_vector_type(4)));
typedef unsigned u32x2 __attribute__((ext_vector_type(2)));

constexpr int BATCH = 4, SEQ = 8192, D = 1024, M = BATCH * SEQ;
constexpr int INW = 4352;
constexpr int C_Q = 0, C_K = 512, C_V = 640, C_ZA = 768, C_UB = 1280, C_ZB = 1792, C_GA = 2304, C_GB = 3328;
constexpr float EPS = 1e-6f;
constexpr float LOG2E = 1.4426950408889634f;
constexpr float QSCALE2 = 0.125f * LOG2E;
constexpr int NWAVES = 8;

constexpr size_t MiB = 1u << 20;
constexpr size_t WS_CTL = 0, CTL_ZERO_BYTES = 65536;
constexpr size_t WS_ROWSQ = 1 * MiB;
constexpr size_t WS_WI = 2 * MiB;
constexpr size_t WS_WAB = 11 * MiB;
constexpr size_t WS_WO = 13 * MiB;
constexpr size_t WS_PW = 15 * MiB;
constexpr size_t WS_H = 16 * MiB;
constexpr size_t WS_PROJ = 80 * MiB;
constexpr size_t WS_AB = 352 * MiB;
constexpr size_t WS_END = 416 * MiB;

__device__ __forceinline__ unsigned f2bf(float f) { unsigned u = __builtin_bit_cast(unsigned, f); return (u + 0x7fffu + ((u >> 16) & 1u)) >> 16; }
__device__ __forceinline__ unsigned pk2(float lo, float hi) { return f2bf(lo) | (f2bf(hi) << 16); }
__device__ __forceinline__ unsigned cvt_pk_bf16(float lo, float hi) { unsigned r; asm volatile("v_cvt_pk_bf16_f32 %0, %1, %2" : "=v"(r) : "v"(lo), "v"(hi)); return r; }
__device__ __forceinline__ float bf_lo(unsigned w) { return __builtin_bit_cast(float, w << 16); }
__device__ __forceinline__ float bf_hi(unsigned w) { return __builtin_bit_cast(float, w & 0xffff0000u); }
__device__ __forceinline__ float sigmoid_den(float g) {
    g = fminf(fmaxf(g, -30.f), 30.f);
    return 1.0f + __builtin_amdgcn_exp2f(-g * LOG2E);
}
__device__ __forceinline__ float silu(float z) { return z * __builtin_amdgcn_rcpf(sigmoid_den(z)); }

namespace pg8 {
constexpr int BM = 256, BK = 64, HALF = 128, HTB = HALF * BK * 2, STAGE_BYTES = 8 * HTB, NXCD = 8, WGM = 8;
__host__ __device__ __forceinline__ int lds_byte(int r, int c) { const int st = (r >> 4) * 2 + (c >> 5), rr = r & 15, cc = c & 31, ob = rr * 64 + cc * 2; return st * 1024 + (ob ^ (((ob >> 9) & 1) << 5)); }
__host__ __device__ __forceinline__ void stage_rc(int b, int& R, int& C) { const int st = b / 1024, sb = b % 1024, swz = sb ^ (((sb >> 9) & 1) << 5); R = (st >> 1) * 16 + swz / 64; C = (st & 1) * 32 + (swz % 64) / 2; }
__host__ __device__ __forceinline__ int perm32(int rho) { const int n = rho >> 4, i = rho & 15; return 8 * (i >> 2) + 4 * n + (i & 3); }

struct Unit { int pm, pn; };
struct Gemm { const bf16_t* A; const bf16_t* Bt; int M, N, K; };

struct StaticOrder {
    int nM, nN, nwg, G, c;
    __device__ void init(int M_, int N_, int G_, int c_) { nM = M_ / BM; nN = N_ / BM; nwg = nM * nN; G = G_; c = c_; }
    __device__ bool next(int i, Unit& u) const {
        const long L = (long)i * G + c; if (L >= nwg) return false;
        int wgid = (int)L; { const int q = nwg / NXCD, r = nwg % NXCD, xcd = wgid % NXCD, off = wgid / NXCD; wgid = (xcd < r ? xcd * (q + 1) : r * (q + 1) + (xcd - r) * q) + off; }
        const int nig = WGM * nN, gid = wgid / nig, fm = gid * WGM, gsz = (nM - fm) < WGM ? (nM - fm) : WGM;
        u.pm = fm + ((wgid % nig) % gsz); u.pn = (wgid % nig) / gsz; return true;
    }
};


struct EpiBf16 {
    static constexpr bool PERM = true, HAS_MID = false;
    bf16_t* O; int ldc;
    __device__ __forceinline__ void mid(f32x4 (&)[2][2][4][2], const Unit&, int, int, int, int) const {}
    __device__ __forceinline__ void operator()(f32x4 (&acc)[2][2][4][2], const Unit& u, int wr, int wc, int fr, int fq) const {
        const int row0 = u.pm * BM + wr * 64 + fr; const int col0 = u.pn * BM + wc * 32 + 8 * fq;
#pragma unroll
        for (int ai = 0; ai < 2; ++ai)
#pragma unroll
            for (int m = 0; m < 4; ++m) { bf16_t* rowp = O + (size_t)(row0 + ai * HALF + m * 16) * ldc + col0;
#pragma unroll
                for (int bj = 0; bj < 2; ++bj) { const f32x4 v0 = acc[ai][bj][m][0], v1 = acc[ai][bj][m][1];
                    u32x4 w; w.x = cvt_pk_bf16(v0[0], v0[1]); w.y = cvt_pk_bf16(v0[2], v0[3]); w.z = cvt_pk_bf16(v1[0], v1[1]); w.w = cvt_pk_bf16(v1[2], v1[3]);
                    *(u32x4*)(rowp + bj * HALF) = w; } }
    }
};

struct EpiMerge {
    static constexpr bool PERM = true, HAS_MID = true;
    const bf16_t* proj; bf16_t* O;
    __device__ __forceinline__ void mid(f32x4 (&acc)[2][2][4][2], const Unit& u, int wr, int wc, int fr, int fq) const {
        int row0 = u.pm * BM + wr * 64 + fr; const int col0 = u.pn * BM + wc * 32 + 8 * fq;
        asm volatile("" : "+v"(row0));
#pragma unroll
        for (int ai = 0; ai < 2; ++ai)
#pragma unroll
            for (int m = 0; m < 4; ++m) { const bf16_t* rowp = proj + (size_t)(row0 + ai * HALF + m * 16) * INW + col0;
#pragma unroll
                for (int bj = 0; bj < 2; ++bj) {
                    const u32x4 ga = *(const u32x4*)(rowp + C_GA + bj * HALF), gb = *(const u32x4*)(rowp + C_GB + bj * HALF);
#pragma unroll
                    for (int j = 0; j < 4; ++j) {
                        const float r0 = sigmoid_den(bf_lo(gb[j])) * __builtin_amdgcn_rcpf(sigmoid_den(bf_lo(ga[j])));
                        const float r1 = sigmoid_den(bf_hi(gb[j])) * __builtin_amdgcn_rcpf(sigmoid_den(bf_hi(ga[j])));
                        acc[ai][bj][m][j >> 1][(j & 1) * 2 + 0] *= r0; acc[ai][bj][m][j >> 1][(j & 1) * 2 + 1] *= r1; } }
                asm volatile("" : "+v"(acc[ai][0][m][0]), "+v"(acc[ai][0][m][1]), "+v"(acc[ai][1][m][0]), "+v"(acc[ai][1][m][1]));
                asm volatile("" ::: "memory"); }
    }
    __device__ __forceinline__ void operator()(f32x4 (&acc)[2][2][4][2], const Unit& u, int wr, int wc, int fr, int fq) const {
        const int row0 = u.pm * BM + wr * 64 + fr; const int col0 = u.pn * BM + wc * 32 + 8 * fq;
#pragma unroll
        for (int ai = 0; ai < 2; ++ai)
#pragma unroll
            for (int m = 0; m < 4; ++m) { const size_t row = (size_t)(row0 + ai * HALF + m * 16);
#pragma unroll
                for (int bj = 0; bj < 2; ++bj) {
                    const u32x4 gb = *(const u32x4*)(proj + row * INW + col0 + C_GB + bj * HALF);
                    float v[8];
#pragma unroll
                    for (int j = 0; j < 4; ++j) {
                        v[2 * j]     = acc[ai][bj][m][j >> 1][(j & 1) * 2 + 0] * __builtin_amdgcn_rcpf(sigmoid_den(bf_lo(gb[j])));
                        v[2 * j + 1] = acc[ai][bj][m][j >> 1][(j & 1) * 2 + 1] * __builtin_amdgcn_rcpf(sigmoid_den(bf_hi(gb[j]))); }
                    u32x4 w; w.x = cvt_pk_bf16(v[0], v[1]); w.y = cvt_pk_bf16(v[2], v[3]); w.z = cvt_pk_bf16(v[4], v[5]); w.w = cvt_pk_bf16(v[6], v[7]);
                    *(u32x4*)(O + row * D + col0 + bj * HALF) = w; }
                asm volatile("" ::: "memory"); }
    }
};

struct EpiOut {
    static constexpr bool PERM = false, HAS_MID = false;
    const float* x; float* out; float* rowsq;
    __device__ __forceinline__ void mid(f32x4 (&)[2][2][4][2], const Unit&, int, int, int, int) const {}
    __device__ __forceinline__ void operator()(f32x4 (&acc)[2][2][4][2], const Unit& u, int wr, int wc, int fr, int fq) const {
        const int row0 = u.pm * BM + wr * 64 + fr; const int col0 = u.pn * BM + wc * 32 + 4 * fq;
#pragma unroll
        for (int ai = 0; ai < 2; ++ai)
#pragma unroll
            for (int m = 0; m < 4; ++m) { const int row = row0 + ai * HALF + m * 16; const size_t off = (size_t)row * D + col0; float s = 0.f;
#pragma unroll
                for (int bj = 0; bj < 2; ++bj)
#pragma unroll
                    for (int n = 0; n < 2; ++n) { const f32x4 xv = *(const f32x4*)(x + off + bj * HALF + n * 16); const f32x4 v = acc[ai][bj][m][n] + xv;
                        s += (v[0] * v[0] + v[1] * v[1]) + (v[2] * v[2] + v[3] * v[3]); *(f32x4*)(out + off + bj * HALF + n * 16) = v; }
                s += __shfl_xor(s, 16); s += __shfl_xor(s, 32);
                if (fq == 0) atomicAdd(rowsq + row, s); }
    }
};

template <class Epi, class Sched, bool ALIGN_EPI = false, bool SP2 = false>
__device__ __forceinline__ void gemm_phase(LAS unsigned char* lds, const Gemm g, const Sched& S, const Epi& E) {
    const int tid = threadIdx.x, wid = __builtin_amdgcn_readfirstlane(tid >> 6), lane = tid & 63, wr = wid >> 2, wc = wid & 3, fr = lane & 15, fq = lane >> 4;
    const int K = g.K, nt = K / BK;
    unsigned voffA[2], voffB[2];
#pragma unroll
    for (int i = 0; i < 2; ++i) { int R, C; stage_rc(tid * 16 + i * 8192, R, C); const int Rb = Epi::PERM ? ((R & ~31) + perm32(R & 31)) : R;
        voffA[i] = (unsigned)(R * K + C) * 2u; voffB[i] = (unsigned)(Rb * K + C) * 2u; }
    const size_t kstep = (size_t)(BK * 2);
    const size_t hstep = (size_t)HALF * K * 2;
    const size_t tstep = 2 * hstep;
    const unsigned ldsw = (unsigned)wid * 1024u;
    const int aoff = lds_byte(wr * 64 + fr, fq * 8), boff = lds_byte(wc * 32 + fr, fq * 8);
#define PG8_SA(b, h) (((b) * 2 + (h)) * HTB)
#define PG8_SB(b, h) ((4 + (b) * 2 + (h)) * HTB)
#define PG8_STAGE(bufoff, gbase, voff) do { _Pragma("unroll") for (int _i = 0; _i < 2; ++_i) \
        __builtin_amdgcn_global_load_lds((const unsigned*)((const char*)(gbase) + (voff)[_i]), (LAS unsigned*)(lds + (bufoff) + ldsw + _i * 8192), 16, 0, 0); } while (0)
#define PG8_LDA(dst, b, h) do { _Pragma("unroll") for (int m = 0; m < 4; ++m) _Pragma("unroll") for (int k = 0; k < 2; ++k) dst[m][k] = *(const LAS bf16x8*)(lds + PG8_SA(b, h) + aoff + m * 2048 + k * 1024); } while (0)
#define PG8_LDB(dst, b, h) do { _Pragma("unroll") for (int n = 0; n < 2; ++n) _Pragma("unroll") for (int k = 0; k < 2; ++k) dst[n][k] = *(const LAS bf16x8*)(lds + PG8_SB(b, h) + boff + n * 2048 + k * 1024); } while (0)
#define PG8_MMA(ai, bj, At, Bt) do { __builtin_amdgcn_s_setprio(1); _Pragma("unroll") for (int m = 0; m < 4; ++m) _Pragma("unroll") for (int n = 0; n < 2; ++n) _Pragma("unroll") for (int k = 0; k < 2; ++k) \
        acc[ai][bj][m][n] = __builtin_amdgcn_mfma_f32_16x16x32_bf16(Bt[n][k], At[m][k], acc[ai][bj][m][n], 0, 0, 0); __builtin_amdgcn_s_setprio(0); } while (0)
#define PG8_WAIT_V(n) asm volatile("s_waitcnt vmcnt(" #n ")" ::: "memory")
#define PG8_WAIT_L(n) asm volatile("s_waitcnt lgkmcnt(" #n ")" ::: "memory")
#define PG8_BAR __builtin_amdgcn_s_barrier()
#define PG8_SCHED __builtin_amdgcn_sched_barrier(0)
    Unit cur, nxt; int ui = 0;
    if (!S.next(0, cur)) return;
    f32x4 acc[2][2][4][2];
#pragma unroll
    for (int a = 0; a < 2; ++a)
#pragma unroll
        for (int b = 0; b < 2; ++b)
#pragma unroll
            for (int m = 0; m < 4; ++m)
#pragma unroll
                for (int n = 0; n < 2; ++n) acc[a][b][m][n] = (f32x4){0.f, 0.f, 0.f, 0.f};
    bf16x8 At[4][2], B0[2][2], B1[2][2];
    const char* cA = (const char*)g.A + (size_t)cur.pm * tstep; const char* cB = (const char*)g.Bt + (size_t)cur.pn * tstep;
    if constexpr (SP2) {
        PG8_STAGE(PG8_SB(0, 0), cB, voffB); PG8_STAGE(PG8_SB(0, 1), cB + hstep, voffB); PG8_STAGE(PG8_SA(0, 0), cA, voffA); PG8_STAGE(PG8_SA(0, 1), cA + hstep, voffA);
        if (wr == 1) PG8_BAR;
        PG8_WAIT_V(2); PG8_BAR;
        PG8_STAGE(PG8_SB(1, 0), cB + kstep, voffB); PG8_STAGE(PG8_SA(1, 0), cA + kstep, voffA); PG8_STAGE(PG8_SB(1, 1), cB + hstep + kstep, voffB);
        PG8_WAIT_V(6); PG8_BAR;
    } else {
        PG8_STAGE(PG8_SB(0, 0), cB, voffB); PG8_STAGE(PG8_SA(0, 0), cA, voffA); PG8_STAGE(PG8_SB(0, 1), cB + hstep, voffB); PG8_STAGE(PG8_SA(0, 1), cA + hstep, voffA);
        if (wr == 1) PG8_BAR;
        PG8_WAIT_V(4); PG8_BAR;
        PG8_STAGE(PG8_SB(1, 0), cB + kstep, voffB); PG8_STAGE(PG8_SA(1, 0), cA + kstep, voffA); PG8_STAGE(PG8_SB(1, 1), cB + hstep + kstep, voffB);
        PG8_WAIT_V(6); PG8_BAR;
    }
    for (;;) {
        const bool has_next = S.next(ui + 1, nxt);
        const char* nA = has_next ? (const char*)g.A + (size_t)nxt.pm * tstep : cA; const char* nB = has_next ? (const char*)g.Bt + (size_t)nxt.pn * tstep : cB;
        for (int t = 0; t < nt; t += 2) {
            const bool last = (t == nt - 2);
            const char* a1 = cA + (size_t)(t + 1) * kstep;
            const char* a2 = last ? nA : cA + (size_t)(t + 2) * kstep; const char* b2 = last ? nB : cB + (size_t)(t + 2) * kstep;
            const char* a3 = a2 + kstep; const char* b3 = b2 + kstep;
            if constexpr (SP2) {
            PG8_LDB(B0, 0, 0); PG8_LDB(B1, 0, 1); PG8_SCHED; PG8_LDA(At, 0, 0); PG8_STAGE(PG8_SA(1, 1), a1 + hstep, voffA);
            PG8_WAIT_V(8); PG8_WAIT_L(0); PG8_BAR; PG8_MMA(0, 0, At, B0); PG8_MMA(0, 1, At, B1); PG8_BAR; PG8_SCHED;
            PG8_LDA(At, 0, 1); PG8_STAGE(PG8_SB(0, 0), b2, voffB); PG8_STAGE(PG8_SB(0, 1), b2 + hstep, voffB); PG8_STAGE(PG8_SA(0, 0), a2, voffA);
            PG8_WAIT_V(8); PG8_WAIT_L(0); PG8_BAR; PG8_MMA(1, 0, At, B0); PG8_MMA(1, 1, At, B1); PG8_BAR; PG8_SCHED;
            PG8_LDB(B0, 1, 0); PG8_LDB(B1, 1, 1); PG8_SCHED; PG8_LDA(At, 1, 0); PG8_STAGE(PG8_SA(0, 1), a2 + hstep, voffA);
            PG8_WAIT_V(8); PG8_WAIT_L(0); PG8_BAR; PG8_MMA(0, 0, At, B0); PG8_MMA(0, 1, At, B1); PG8_BAR; PG8_SCHED;
            PG8_LDA(At, 1, 1); PG8_STAGE(PG8_SB(1, 0), b3, voffB); PG8_STAGE(PG8_SB(1, 1), b3 + hstep, voffB); PG8_STAGE(PG8_SA(1, 0), a3, voffA);
            PG8_WAIT_V(8); PG8_WAIT_L(0); PG8_BAR; PG8_MMA(1, 0, At, B0); PG8_MMA(1, 1, At, B1); PG8_BAR; PG8_SCHED;
            } else {
            PG8_LDB(B0, 0, 0); PG8_SCHED; PG8_LDA(At, 0, 0); PG8_STAGE(PG8_SA(1, 1), a1 + hstep, voffA);
            PG8_WAIT_L(8); PG8_BAR; PG8_WAIT_L(0); PG8_MMA(0, 0, At, B0); PG8_BAR; PG8_SCHED;
            PG8_LDB(B1, 0, 1); PG8_STAGE(PG8_SB(0, 0), b2, voffB);
            PG8_BAR; PG8_WAIT_L(0); PG8_MMA(0, 1, At, B1); PG8_BAR;
            PG8_LDA(At, 0, 1); PG8_STAGE(PG8_SA(0, 0), a2, voffA);
            PG8_BAR; PG8_WAIT_L(0); PG8_MMA(1, 0, At, B0); PG8_BAR; PG8_SCHED;
            PG8_STAGE(PG8_SB(0, 1), b2 + hstep, voffB);
            PG8_WAIT_V(6); PG8_BAR; PG8_MMA(1, 1, At, B1); PG8_BAR;
            PG8_LDB(B0, 1, 0); PG8_SCHED; PG8_LDA(At, 1, 0); PG8_STAGE(PG8_SA(0, 1), a2 + hstep, voffA);
            PG8_WAIT_L(8); PG8_BAR; PG8_WAIT_L(0); PG8_MMA(0, 0, At, B0); PG8_BAR; PG8_SCHED;
            PG8_LDB(B1, 1, 1); PG8_STAGE(PG8_SB(1, 0), b3, voffB);
            PG8_BAR; PG8_WAIT_L(0); PG8_MMA(0, 1, At, B1); PG8_BAR;
            PG8_LDA(At, 1, 1); PG8_STAGE(PG8_SA(1, 0), a3, voffA);
            PG8_BAR; PG8_WAIT_L(0); PG8_MMA(1, 0, At, B0); PG8_BAR; PG8_SCHED;
            PG8_STAGE(PG8_SB(1, 1), b3 + hstep, voffB);
            PG8_WAIT_V(6); PG8_BAR; PG8_MMA(1, 1, At, B1); PG8_BAR;
            }
            if constexpr (Epi::HAS_MID) { if (t == nt / 2 - 2) { asm volatile("" ::: "memory"); E.mid(acc, cur, wr, wc, fr, fq); asm volatile("" ::: "memory"); } }
        }
        if constexpr (ALIGN_EPI) { if (wr == 0) PG8_BAR; }
        E(acc, cur, wr, wc, fr, fq);
        if (!has_next) break;
#pragma unroll
        for (int a = 0; a < 2; ++a)
#pragma unroll
            for (int b = 0; b < 2; ++b)
#pragma unroll
                for (int m = 0; m < 4; ++m)
#pragma unroll
                    for (int n = 0; n < 2; ++n) acc[a][b][m][n] = (f32x4){0.f, 0.f, 0.f, 0.f};
        cur = nxt; cA = nA; cB = nB; ++ui;
        if constexpr (ALIGN_EPI) { if (wr == 1) PG8_BAR; }
    }
    PG8_WAIT_V(0);
    if constexpr (!ALIGN_EPI) { if (wr == 0) PG8_BAR; }
    PG8_BAR;
#undef PG8_SA
#undef PG8_SB
#undef PG8_STAGE
#undef PG8_LDA
#undef PG8_LDB
#undef PG8_MMA
#undef PG8_WAIT_V
#undef PG8_WAIT_L
#undef PG8_BAR
#undef PG8_SCHED
}
}

constexpr int RING_BYTES = 131072;
constexpr int LDSCTL_OFF = RING_BYTES, MISC_OFF = LDSCTL_OFF + 320;
constexpr int LDS_BYTES = 147456;

#define XB_TMO      128
#define XB_XCNT(j)  (256  + 64 * (j))
#define XB_XSUB(j)  (1280 + 64 * (j))
#define XB_XGEN(j)  (2304 + 64 * (j))
#define XB_TOP      3328
#define XB_TOPGEN   3392
#define XCD_BAR_WORDS 3456
#define XB_SPIN_CAP (1u << 18)
__device__ __forceinline__ unsigned xb_ld(unsigned* p)              { return __hip_atomic_load(p, __ATOMIC_RELAXED, __HIP_MEMORY_SCOPE_AGENT); }
__device__ __forceinline__ unsigned xb_add(unsigned* p, unsigned v) { return __hip_atomic_fetch_add(p, v, __ATOMIC_RELAXED, __HIP_MEMORY_SCOPE_AGENT); }
__device__ __forceinline__ unsigned xb_xcc_id() { return (unsigned)__builtin_amdgcn_s_getreg((3 << 11) | 20) & 0xFu; }
#define XB_SPIN(cond, bar) do { unsigned _sp = 0; while (cond) { __builtin_amdgcn_s_sleep(1); \
    if ((++_sp & 255u) == 0u) { if (xb_ld(&(bar)[XB_TMO])) break; if (_sp > XB_SPIN_CAP) { atomicAdd(&(bar)[XB_TMO], 1u); break; } } } } while (0)
struct XcdBarrier { unsigned* bar; unsigned x; volatile LAS unsigned* st; };
__device__ __forceinline__ XcdBarrier xcd_barrier_post(unsigned* bar, volatile LAS unsigned* st) {
    XcdBarrier b; b.bar = bar; b.x = xb_xcc_id(); b.st = st;
    if (threadIdx.x == 0) (void)xb_add(&bar[XB_XCNT(b.x)], 1u);
    return b;
}
__device__ __forceinline__ void xcd_barrier_complete(unsigned* bar, unsigned x, unsigned& nloc, unsigned& nx) {
    const unsigned G = gridDim.x * gridDim.y * gridDim.z;
    unsigned sum, cnt, mine, sp = 0u;
    for (;;) {
        sum = 0u; cnt = 0u; mine = 0u;
#pragma unroll
        for (unsigned j = 0; j < 16; ++j) { const unsigned c = xb_ld(&bar[XB_XCNT(j)]); sum += c; cnt += (c > 0u) ? 1u : 0u; mine = (j == x) ? c : mine; }
        if (sum == G) break;
        __builtin_amdgcn_s_sleep(1);
        if ((++sp & 255u) == 0u) { if (xb_ld(&bar[XB_TMO])) break; if (sp > XB_SPIN_CAP) { atomicAdd(&bar[XB_TMO], 1u); break; } }
    }
    nloc = mine > 0u ? mine : 1u; nx = cnt > 0u ? cnt : 1u;
}
__device__ __forceinline__ void xcd_barrier(const XcdBarrier& b) {
    asm volatile("s_waitcnt vmcnt(0)" ::: "memory");
    __syncthreads();
    if (threadIdx.x == 0) {
        unsigned* bar = b.bar;
        __builtin_amdgcn_s_waitcnt(0);
        unsigned nloc = b.st[0], nx = b.st[1];
        if (nloc == 0u) { xcd_barrier_complete(bar, b.x, nloc, nx); b.st[0] = nloc; b.st[1] = nx; }
        const unsigned old = xb_add(&bar[XB_XSUB(b.x)], 1u);
        const unsigned gen = old / nloc;
        if (old + 1u == (gen + 1u) * nloc) {
            __builtin_amdgcn_fence(__ATOMIC_RELEASE, "agent");
            asm volatile("s_waitcnt vmcnt(0)" ::: "memory");
            const unsigned og = xb_add(&bar[XB_TOP], 1u);
            const unsigned tg = og / nx;
            if (og + 1u == (tg + 1u) * nx) xb_add(&bar[XB_TOPGEN], 1u);
            else XB_SPIN(xb_ld(&bar[XB_TOPGEN]) == tg, bar);
            __builtin_amdgcn_fence(__ATOMIC_ACQUIRE, "agent");
            xb_add(&bar[XB_XGEN(b.x)], 1u);
            asm volatile("s_waitcnt vmcnt(0)" ::: "memory");
        } else {
            XB_SPIN(xb_ld(&bar[XB_XGEN(b.x)]) == gen, bar);
            __builtin_amdgcn_fence(__ATOMIC_ACQUIRE, "agent");
            asm volatile("s_waitcnt vmcnt(0)" ::: "memory");
        }
    }
    __syncthreads();
}

__device__ __forceinline__ float wave_sum(float v) {
#pragma unroll
    for (int o = 1; o < 64; o <<= 1) v += __shfl_xor(v, o);
    return v;
}
__device__ __forceinline__ void p0_transpose_item(const float* W, int ldn, int k0, int n0, bf16_t* WT, int ldk, int kdst0, float scale, LAS float* scr, int lane) {
#pragma unroll 8
    for (int i = 0; i < 32; ++i) { const int kk = 2 * i + (lane >> 5); scr[kk * 33 + (lane & 31)] = W[(size_t)(k0 + kk) * ldn + n0 + (lane & 31)] * scale; }
    asm volatile("s_waitcnt lgkmcnt(0)" ::: "memory");
    const int c = lane & 7;
#pragma unroll
    for (int j = 0; j < 4; ++j) { const int n = (lane >> 3) + 8 * j; const LAS float* s = scr + (8 * c) * 33 + n;
        u32x4 o; o.x = pk2(s[0 * 33], s[1 * 33]); o.y = pk2(s[2 * 33], s[3 * 33]); o.z = pk2(s[4 * 33], s[5 * 33]); o.w = pk2(s[6 * 33], s[7 * 33]);
        *(u32x4*)(WT + (size_t)(n0 + n) * ldk + kdst0 + k0 + 8 * c) = o; }
    asm volatile("s_waitcnt lgkmcnt(0)" ::: "memory");
}

struct Ptrs {
    const float *x, *norm_g, *w_in, *sink, *pool_w, *pool_scale, *w_a, *w_b, *w_out, *fin_g;
    float* out; float* rowsq;
    bf16_t *Wi, *Wab, *Wo, *Pw, *H, *PROJ, *AB;
};

__device__ __forceinline__ void p0_prologue(const Ptrs& P, LAS unsigned char* lds, int vcu, int G, int wave, int lane) {
    LAS float* scr = (LAS float*)(lds + wave * 16384);
    const int gw = vcu * NWAVES + wave, NGW = G * NWAVES;
    constexpr int I_IN = (D / 64) * (INW / 32), I_A = (512 / 64) * (D / 32), I_O = (D / 64) * (D / 32), I_P = 4 * 2 * 4;
    constexpr int NITEMS = I_IN + 2 * I_A + I_O + I_P;
    for (int it = gw; it < NITEMS; it += NGW) {
        int r = it;
        if (r < I_IN) { const int nblk = INW / 32, kb = r / nblk, nb = r % nblk; p0_transpose_item(P.w_in, INW, 64 * kb, 32 * nb, P.Wi, D, 0, (32 * nb < 512) ? QSCALE2 : 1.0f, scr, lane); continue; } r -= I_IN;
        if (r < I_A) { const int nblk = D / 32, kb = r / nblk, nb = r % nblk; p0_transpose_item(P.w_a, D, 64 * kb, 32 * nb, P.Wab, D, 0, 1.0f, scr, lane); continue; } r -= I_A;
        if (r < I_A) { const int nblk = D / 32, kb = r / nblk, nb = r % nblk; p0_transpose_item(P.w_b, D, 64 * kb, 32 * nb, P.Wab, D, 512, 1.0f, scr, lane); continue; } r -= I_A;
        if (r < I_O) { const int nblk = D / 32, kb = r / nblk, nb = r % nblk; p0_transpose_item(P.w_out, D, 64 * kb, 32 * nb, P.Wo, D, 0, 1.0f, scr, lane); continue; } r -= I_O;
        { const int g = r / 8, q = r % 8, kb = q / 4, nb = q % 4; p0_transpose_item(P.pool_w + (size_t)g * 128 * 128, 128, 64 * kb, 32 * nb, P.Pw + (size_t)g * 128 * 128, 128, 0, 1.0f, scr, lane); }
    }
    f32x4 gv[4];
#pragma unroll
    for (int j = 0; j < 4; ++j) gv[j] = *((const f32x4*)P.norm_g + lane + 64 * j);
    for (int m = gw; m < M; m += NGW) {
        const f32x4* xr = (const f32x4*)(P.x + (size_t)m * D) + lane;
        f32x4 v[4]; float s = 0.f;
#pragma unroll
        for (int j = 0; j < 4; ++j) { v[j] = xr[64 * j]; s += (v[j].x * v[j].x + v[j].y * v[j].y) + (v[j].z * v[j].z + v[j].w * v[j].w); }
        const float rs = 1.0f / sqrtf(wave_sum(s) * (1.f / D) + EPS);
        unsigned long long* o8 = (unsigned long long*)(P.H + (size_t)m * D) + lane;
#pragma unroll
        for (int j = 0; j < 4; ++j) { const f32x4 h = v[j] * rs * gv[j]; o8[64 * j] = (unsigned long long)pk2(h.x, h.y) | ((unsigned long long)pk2(h.z, h.w) << 32); }
    }
    for (int i = gw * 64 + lane; i < M; i += NGW * 64) P.rowsq[i] = 0.f;
}

namespace att {
constexpr int LDS_K = 0, LDS_V = 384 * 128;
__device__ __forceinline__ int crow(int r, int hi) { return (r & 3) + 8 * (r >> 2) + 4 * hi; }
__device__ __forceinline__ float swap_max(float v) { auto rr = __builtin_amdgcn_permlane32_swap(__float_as_uint(v), __float_as_uint(v), false, false); return fmaxf(__uint_as_float(rr[0]), __uint_as_float(rr[1])); }
__device__ __forceinline__ float swap_sum(float v) { auto rr = __builtin_amdgcn_permlane32_swap(__float_as_uint(v), __float_as_uint(v), false, false); return __uint_as_float(rr[0]) + __uint_as_float(rr[1]); }
__device__ __forceinline__ s16x4 vtr(const LAS unsigned char* p) { return __builtin_bit_cast(s16x4, __builtin_amdgcn_ds_read_tr16_b64_v4i16((LAS s16x4*)p)); }

__device__ __forceinline__ void attn_unit(LAS unsigned char* lds, const bf16_t* proj, bf16_t* AB, const float* sink, int b, int nb, int hk) {
    const int tid = threadIdx.x, lane = tid & 63, wid = __builtin_amdgcn_readfirstlane(tid >> 6);
    const int t0 = nb * 128; const size_t rowbase = (size_t)b * SEQ;
#pragma unroll
    for (int i = 0; i < 6; ++i) {
        const int row = (tid >> 3) + 64 * i, ch = tid & 7, s = t0 - 128 + row;
        if (s >= 0 && s < SEQ) {
            const bf16_t* src = proj + (rowbase + s) * INW + C_K + hk * 64 + ch * 8;
            const u32x4 kv = *(const u32x4*)src, vv = *(const u32x4*)(src + (C_V - C_K));
            *(LAS u32x4*)(lds + LDS_K + row * 128 + ((ch ^ ((row >> 1) & 7)) << 4)) = kv;
            *(LAS u32x4*)(lds + LDS_V + row * 128 + ((ch ^ (((row >> 1) & 1) << 2)) << 4)) = vv;
        }
    }
    __syncthreads();
    const int g = wid & 3, rh = wid >> 2, hq = hk * 4 + g;
    const int q = lane & 31, hi = lane >> 5;
    const float slope2 = __builtin_amdgcn_exp2f(-(float)(hq + 1)) * LOG2E;
    const float sink2 = sink[hq] * LOG2E;
    int koff[4];
#pragma unroll
    for (int ks = 0; ks < 4; ++ks) koff[ks] = LDS_K + q * 128 + (((2 * ks + hi) ^ ((q >> 1) & 7)) << 4);
    const int i16 = lane & 15, qd = i16 >> 2, pp = i16 & 3, g1 = (lane >> 4) & 1;
    int vbase[2];
#pragma unroll
    for (int db = 0; db < 2; ++db) vbase[db] = LDS_V + (4 * hi + qd) * 128 + ((32 * g1 + 8 * pp + 64 * db) ^ (((qd >> 1) & 1) << 6));
#pragma unroll 1
    for (int sbi = 0; sbi < 2; ++sbi) {
        const int sb = 2 * rh + sbi;
        const int tq = t0 + 32 * sb + q;
        const bf16_t* qp = proj + (rowbase + tq) * INW + C_Q + hq * 64 + hi * 8;
        bf16x8 qr[4];
#pragma unroll
        for (int ks = 0; ks < 4; ++ks) qr[ks] = *(const bf16x8*)(qp + 16 * ks);
        float mrun = sink2, l = (hi == 0) ? 1.0f : 0.0f;
        f32x16 o0, o1;
#pragma unroll
        for (int r = 0; r < 16; ++r) { o0[r] = 0.f; o1[r] = 0.f; }
#pragma unroll 1
        for (int c = 0; c < 9; ++c) {
            const int cb = 32 * (sb + c);
            const int s0 = t0 - 128 + cb;
            if (s0 < 0 || s0 >= SEQ) continue;
            const LAS unsigned char* kb = lds + cb * 128;
            f32x16 p;
#pragma unroll
            for (int r = 0; r < 16; ++r) p[r] = 0.f;
#pragma unroll
            for (int ks = 0; ks < 4; ++ks) { const bf16x8 kf = *(const LAS bf16x8*)(kb + koff[ks]); p = __builtin_amdgcn_mfma_f32_32x32x16_bf16(kf, qr[ks], p, 0, 0, 0); }
            const int dbase = q + 128 - 32 * c - 4 * hi;
            float rm = -1e30f;
#pragma unroll
            for (int r = 0; r < 16; ++r) { const float dist = fabsf((float)(dbase - ((r & 3) + 8 * (r >> 2))));
                float sc = p[r] - slope2 * dist; sc = (dist <= 128.0f) ? sc : -1e30f; p[r] = sc; rm = fmaxf(rm, sc); }
            rm = swap_max(rm);
            const float mn = fmaxf(mrun, rm); const float alpha = __builtin_amdgcn_exp2f(mrun - mn); mrun = mn;
            float ps = 0.f;
#pragma unroll
            for (int r = 0; r < 16; ++r) { p[r] = __builtin_amdgcn_exp2f(p[r] - mn); ps += p[r]; }
            l = l * alpha + ps;
            if (__builtin_amdgcn_ballot_w64(alpha != 1.0f) != 0ull) {
#pragma unroll
                for (int r = 0; r < 16; ++r) { o0[r] *= alpha; o1[r] *= alpha; } }
            u32x4 w0, w1;
            w0.x = cvt_pk_bf16(p[0], p[1]); w0.y = cvt_pk_bf16(p[2], p[3]); w0.z = cvt_pk_bf16(p[4], p[5]); w0.w = cvt_pk_bf16(p[6], p[7]);
            w1.x = cvt_pk_bf16(p[8], p[9]); w1.y = cvt_pk_bf16(p[10], p[11]); w1.z = cvt_pk_bf16(p[12], p[13]); w1.w = cvt_pk_bf16(p[14], p[15]);
            const bf16x8 pb0 = __builtin_bit_cast(bf16x8, w0), pb1 = __builtin_bit_cast(bf16x8, w1);
            const LAS unsigned char* vb0 = lds + cb * 128 + vbase[0]; const LAS unsigned char* vb1 = lds + cb * 128 + vbase[1];
            { const s16x4 a = vtr(vb0), bq = vtr(vb0 + 8 * 128); const bf16x8 va = (bf16x8){a[0], a[1], a[2], a[3], bq[0], bq[1], bq[2], bq[3]};
              o0 = __builtin_amdgcn_mfma_f32_32x32x16_bf16(va, pb0, o0, 0, 0, 0); }
            { const s16x4 a = vtr(vb0 + 16 * 128), bq = vtr(vb0 + 24 * 128); const bf16x8 va = (bf16x8){a[0], a[1], a[2], a[3], bq[0], bq[1], bq[2], bq[3]};
              o0 = __builtin_amdgcn_mfma_f32_32x32x16_bf16(va, pb1, o0, 0, 0, 0); }
            { const s16x4 a = vtr(vb1), bq = vtr(vb1 + 8 * 128); const bf16x8 va = (bf16x8){a[0], a[1], a[2], a[3], bq[0], bq[1], bq[2], bq[3]};
              o1 = __builtin_amdgcn_mfma_f32_32x32x16_bf16(va, pb0, o1, 0, 0, 0); }
            { const s16x4 a = vtr(vb1 + 16 * 128), bq = vtr(vb1 + 24 * 128); const bf16x8 va = (bf16x8){a[0], a[1], a[2], a[3], bq[0], bq[1], bq[2], bq[3]};
              o1 = __builtin_amdgcn_mfma_f32_32x32x16_bf16(va, pb1, o1, 0, 0, 0); }
        }
        l = swap_sum(l);
        const float inv = 1.0f / l;
        const bf16_t* zp = proj + (rowbase + tq) * INW + C_ZA + hq * 64 + 4 * hi;
        bf16_t* op = AB + (rowbase + tq) * D + hq * 64 + 4 * hi;
#pragma unroll
        for (int k4 = 0; k4 < 4; ++k4) {
            { const u32x2 z = *(const u32x2*)(zp + 8 * k4);
              const float v0 = o0[4 * k4 + 0] * inv * silu(bf_lo(z.x)), v1 = o0[4 * k4 + 1] * inv * silu(bf_hi(z.x)), v2 = o0[4 * k4 + 2] * inv * silu(bf_lo(z.y)), v3 = o0[4 * k4 + 3] * inv * silu(bf_hi(z.y));
              u32x2 w; w.x = cvt_pk_bf16(v0, v1); w.y = cvt_pk_bf16(v2, v3); *(u32x2*)(op + 8 * k4) = w; }
            { const u32x2 z = *(const u32x2*)(zp + 32 + 8 * k4);
              const float v0 = o1[4 * k4 + 0] * inv * silu(bf_lo(z.x)), v1 = o1[4 * k4 + 1] * inv * silu(bf_hi(z.x)), v2 = o1[4 * k4 + 2] * inv * silu(bf_lo(z.y)), v3 = o1[4 * k4 + 3] * inv * silu(bf_hi(z.y));
              u32x2 w; w.x = cvt_pk_bf16(v0, v1); w.y = cvt_pk_bf16(v2, v3); *(u32x2*)(op + 32 + 8 * k4) = w; }
        }
    }
    __syncthreads();
}
}

namespace pool {
template <int W> __device__ __forceinline__ void pool_rows(LAS unsigned char* lds, const Ptrs& P, int m0, int g, int wid, int lane) {
    const int row = lane & 31, hi = lane >> 5;
    const int m = m0 + 32 * wid + row, t = m & (SEQ - 1);
    const int lo = (t - W / 2) < 0 ? 0 : (t - W / 2), hb = (t + W / 2) > SEQ ? SEQ : (t + W / 2);
    const float inv = 1.0f / (float)(hb - lo);
    const int rc = 8 + 32 * wid + row;
    f32x16 acc[4];
#pragma unroll
    for (int db = 0; db < 4; ++db)
#pragma unroll
        for (int r = 0; r < 16; ++r) acc[db][r] = 0.f;
    const bf16_t* pw = P.Pw + ((size_t)g * 128 + row) * 128 + 8 * hi;
#pragma unroll 2
    for (int ks = 0; ks < 8; ++ks) {
        const int ch = 2 * ks + hi;
        float sum[8], self[8];
#pragma unroll
        for (int j = 0; j < 8; ++j) { sum[j] = 0.f; self[j] = 0.f; }
#pragma unroll
        for (int o = -W / 2; o < W / 2; ++o) {
            const int rr = rc + o; const bool ok = (t + o >= 0) && (t + o < SEQ);
            const u32x4 v = *(const LAS u32x4*)(lds + rr * 256 + ((ch ^ (rr & 15)) << 4));
            float f[8];
#pragma unroll
            for (int j = 0; j < 4; ++j) { f[2 * j] = bf_lo(v[j]); f[2 * j + 1] = bf_hi(v[j]); }
#pragma unroll
            for (int j = 0; j < 8; ++j) { sum[j] += ok ? f[j] : 0.f; if (o == 0) self[j] = f[j]; }
        }
        u32x4 w;
        w.x = cvt_pk_bf16(sum[0] * inv - self[0], sum[1] * inv - self[1]); w.y = cvt_pk_bf16(sum[2] * inv - self[2], sum[3] * inv - self[3]);
        w.z = cvt_pk_bf16(sum[4] * inv - self[4], sum[5] * inv - self[5]); w.w = cvt_pk_bf16(sum[6] * inv - self[6], sum[7] * inv - self[7]);
        const bf16x8 pk = __builtin_bit_cast(bf16x8, w);
#pragma unroll
        for (int db = 0; db < 4; ++db) { const bf16x8 a = *(const bf16x8*)(pw + (size_t)db * 32 * 128 + 16 * ks); acc[db] = __builtin_amdgcn_mfma_f32_32x32x16_bf16(a, pk, acc[db], 0, 0, 0); }
    }
    const bf16_t* zp = P.PROJ + (size_t)m * INW + C_ZB + g * 128 + 4 * hi;
    const float* sp = P.pool_scale + g * 128 + 4 * hi;
    bf16_t* op = P.AB + (size_t)m * D + 512 + g * 128 + 4 * hi;
#pragma unroll
    for (int db = 0; db < 4; ++db)
#pragma unroll
        for (int k4 = 0; k4 < 4; ++k4) { const int d = 32 * db + 8 * k4;
            const u32x2 z = *(const u32x2*)(zp + d); const f32x4 sc = *(const f32x4*)(sp + d);
            const float v0 = acc[db][4 * k4 + 0] * sc[0] * silu(bf_lo(z.x)), v1 = acc[db][4 * k4 + 1] * sc[1] * silu(bf_hi(z.x));
            const float v2 = acc[db][4 * k4 + 2] * sc[2] * silu(bf_lo(z.y)), v3 = acc[db][4 * k4 + 3] * sc[3] * silu(bf_hi(z.y));
            u32x2 w; w.x = cvt_pk_bf16(v0, v1); w.y = cvt_pk_bf16(v2, v3); *(u32x2*)(op + d) = w; }
}
__device__ __forceinline__ void pool_unit(LAS unsigned char* lds, const Ptrs& P, int tile, int g) {
    const int tid = threadIdx.x, lane = tid & 63, wid = __builtin_amdgcn_readfirstlane(tid >> 6);
    const int m0 = tile * 256;
    for (int i = tid; i < 272 * 16; i += NWAVES * 64) {
        const int rr = i >> 4, ch = i & 15; int mm = m0 - 8 + rr; mm = mm < 0 ? 0 : (mm > M - 1 ? M - 1 : mm);
        const u32x4 v = *(const u32x4*)(P.PROJ + (size_t)mm * INW + C_UB + g * 128 + ch * 8);
        *(LAS u32x4*)(lds + rr * 256 + ((ch ^ (rr & 15)) << 4)) = v;
    }
    __syncthreads();
    if (g == 0) pool_rows<2>(lds, P, m0, g, wid, lane);
    else if (g == 1) pool_rows<4>(lds, P, m0, g, wid, lane);
    else if (g == 2) pool_rows<8>(lds, P, m0, g, wid, lane);
    else pool_rows<16>(lds, P, m0, g, wid, lane);
    __syncthreads();
}
}

struct Args { const float* in[10]; float* out; unsigned char* ws; int ph_lo, ph_hi; };
constexpr int N_PHASES = 6;

__global__ void __launch_bounds__(NWAVES * 64, 2) fwd_megakernel(Args args) {
    extern __shared__ __attribute__((aligned(16))) unsigned char lds_raw[];
    LAS unsigned char* lds = (LAS unsigned char*)lds_raw;
    cg::grid_group grid = cg::this_grid();
    const int tid = threadIdx.x, lane = tid & 63, wave = __builtin_amdgcn_readfirstlane(tid >> 6);
    const int G = gridDim.x, bx = blockIdx.x;
    const int vcu = (G % 8 == 0) ? (bx % 8) * (G / 8) + bx / 8 : bx;
    Ptrs P;
    P.x = args.in[0]; P.norm_g = args.in[1]; P.w_in = args.in[2]; P.sink = args.in[3]; P.pool_w = args.in[4]; P.pool_scale = args.in[5];
    P.w_a = args.in[6]; P.w_b = args.in[7]; P.w_out = args.in[8]; P.fin_g = args.in[9]; P.out = args.out;
    unsigned char* ws = args.ws;
    P.rowsq = (float*)(ws + WS_ROWSQ); P.Wi = (bf16_t*)(ws + WS_WI); P.Wab = (bf16_t*)(ws + WS_WAB); P.Wo = (bf16_t*)(ws + WS_WO); P.Pw = (bf16_t*)(ws + WS_PW);
    P.H = (bf16_t*)(ws + WS_H); P.PROJ = (bf16_t*)(ws + WS_PROJ); P.AB = (bf16_t*)(ws + WS_AB);
    const int lo = args.ph_lo, hi = args.ph_hi;
    for (int u = tid; u < (LDS_BYTES - LDSCTL_OFF) / 4; u += NWAVES * 64) ((LAS unsigned*)(lds + LDSCTL_OFF))[u] = 0u;
    __syncthreads();
    XcdBarrier bar = xcd_barrier_post((unsigned*)(ws + WS_CTL), (volatile LAS unsigned*)(lds + MISC_OFF) + 8);
    if (lo < 0) grid.sync();
#define GRID_BAR() xcd_barrier(bar)
#ifndef PHASE_MASK
#define PHASE_MASK 63
#endif
#define IN(k) (((PHASE_MASK >> (k)) & 1) && lo <= (k) && (k) < hi)
#define BOTH(k) (IN(k) && IN((k) + 1))

    if (IN(0)) { p0_prologue(P, lds, vcu, G, wave, lane); if (BOTH(0)) GRID_BAR(); }

    if (IN(1)) {
        pg8::Gemm g{P.H, P.Wi, M, INW, D}; pg8::StaticOrder S; S.init(M, INW, G, bx);
        pg8::EpiBf16 E{P.PROJ, INW};
        pg8::gemm_phase<pg8::EpiBf16, pg8::StaticOrder, true, true>(lds, g, S, E);
        if (BOTH(1)) GRID_BAR();
    }

    if (IN(2)) {
        for (int u = vcu; u < BATCH * 64 * 2; u += G) { const int hk = u & 1, nb = (u >> 1) & 63, b = u >> 7; att::attn_unit(lds, P.PROJ, P.AB, P.sink, b, nb, hk); }
        for (int u = vcu; u < (M / 256) * 4; u += G) { const int g = u & 3, tile = u >> 2; pool::pool_unit(lds, P, tile, g); }
        if (BOTH(2)) GRID_BAR();
    }

    if (IN(3)) {
        pg8::Gemm g{P.AB, P.Wab, M, D, D}; pg8::StaticOrder S; S.init(M, D, G, bx);
        pg8::EpiMerge E{P.PROJ, P.H};
        pg8::gemm_phase<pg8::EpiMerge, pg8::StaticOrder, true, true>(lds, g, S, E);
        if (BOTH(3)) GRID_BAR();
    }

    if (IN(4)) {
        pg8::Gemm g{P.H, P.Wo, M, D, D}; pg8::StaticOrder S; S.init(M, D, G, bx);
        pg8::EpiOut E{P.x, P.out, P.rowsq};
        pg8::gemm_phase<pg8::EpiOut, pg8::StaticOrder, true, true>(lds, g, S, E);
        if (BOTH(4)) GRID_BAR();
    }

    if (IN(5)) {
        const int gw = vcu * NWAVES + wave, NGW = G * NWAVES;
        f32x4 gv[4];
#pragma unroll
        for (int j = 0; j < 4; ++j) gv[j] = *((const f32x4*)P.fin_g + lane + 64 * j);
        for (int m = gw; m < M; m += NGW) {
            f32x4* xr = (f32x4*)(P.out + (size_t)m * D) + lane;
            const float rs = 1.0f / sqrtf(P.rowsq[m] * (1.f / D) + EPS);
#pragma unroll
            for (int j = 0; j < 4; ++j) { const f32x4 v = xr[64 * j]; xr[64 * j] = v * rs * gv[j]; }
        }
    }
#undef IN
#undef BOTH
}

#ifndef MK_N_LAUNCHES
#define MK_N_LAUNCHES 1
#endif
extern "C" void kernel_launch(void* const* d_in, const int* in_sizes, int n_in, void* d_out, int out_size, void* d_ws, size_t ws_size, hipStream_t stream) {
    static int grid = 0;
    if (grid == 0) {
        if (n_in != 10 || in_sizes[0] != M * D || out_size != M * D || ws_size < WS_END) { fprintf(stderr, "kernel_launch: unexpected shapes / workspace (n_in %d, in0 %d, out %d, ws %zu)\n", n_in, n_in > 0 ? in_sizes[0] : -1, out_size, ws_size); grid = -1; return; }
        int dev = 0, cus = 0, per_cu = 0;
        if (hipGetDevice(&dev) != hipSuccess || hipDeviceGetAttribute(&cus, hipDeviceAttributeMultiprocessorCount, dev) != hipSuccess) { grid = -1; return; }
        if (hipFuncSetAttribute((const void*)fwd_megakernel, hipFuncAttributeMaxDynamicSharedMemorySize, LDS_BYTES) != hipSuccess) { fprintf(stderr, "kernel_launch: hipFuncSetAttribute failed\n"); grid = -1; return; }
        if (hipOccupancyMaxActiveBlocksPerMultiprocessor(&per_cu, (const void*)fwd_megakernel, NWAVES * 64, LDS_BYTES) != hipSuccess || per_cu < 1) { fprintf(stderr, "kernel_launch: occupancy query says %d blocks per CU\n", per_cu); (void)hipGetLastError(); per_cu = 1; }
        grid = cus * 1;
    }
    if (grid < 0) return;
    if (hipMemsetAsync((char*)d_ws + WS_CTL, 0, CTL_ZERO_BYTES, stream) != hipSuccess) { fprintf(stderr, "kernel_launch: memset failed\n"); return; }
    Args a{};
    for (int i = 0; i < 10; ++i) a.in[i] = (const float*)d_in[i];
    a.out = (float*)d_out; a.ws = (unsigned char*)d_ws;
#if MK_N_LAUNCHES == 1
    a.ph_lo = 0; a.ph_hi = N_PHASES;
    void* kargs[] = {&a};
    hipError_t e = hipLaunchCooperativeKernel((const void*)fwd_megakernel, dim3(grid), dim3(NWAVES * 64), kargs, LDS_BYTES, stream);
    if (e != hipSuccess) fprintf(stderr, "kernel_launch: cooperative launch failed: %s (grid %d)\n", hipGetErrorString(e), grid);
#else
    for (int li = 0; li < N_PHASES; ++li) { a.ph_lo = li; a.ph_hi = li + 1; hipLaunchKernelGGL(fwd_megakernel, dim3(grid), dim3(NWAVES * 64), LDS_BYTES, stream, a); }
#endif
}
```
